# Optimizing an MI355X kernel written in HIP

```python
import math
import jax, jax.numpy as jnp
from jax import lax
import numpy as np

D_MODEL = 1024
BATCH = 16
SEQ = 4096
DEPTH = 2
DEC_BATCH = 8
DEC_SEQ = 2048
PAST_LEN = 128

N_BRANCH = 4
BRANCH_W = D_MODEL // 4
N_GROUPS = 4
GROUP_DIM = BRANCH_W // N_GROUPS
D_FF = 2816
CHUNK = 128
POOL_WINDOWS = (2, 4, 8, 16)
CONV_WIDTH = 3
LN_EPS = 1e-5
ALPHA = (2.0 * DEPTH) ** 0.25
BETA = (8.0 * DEPTH) ** -0.25
IN_SPLITS = (BRANCH_W, 2 * BRANCH_W, 3 * BRANCH_W, 4 * BRANCH_W, 6 * BRANCH_W)
IN_WIDTH = 7 * BRANCH_W

kernel_name = "hybrid_gated_parallel_encoder"


def _layer_norm(x, g, b):
    xf = x.astype(jnp.float32)
    mu = jnp.mean(xf, axis=-1, keepdims=True)
    var = jnp.mean(jnp.square(xf - mu), axis=-1, keepdims=True)
    y = (xf - mu) * lax.rsqrt(var + LN_EPS)
    return (y * g.astype(jnp.float32) + b.astype(jnp.float32)).astype(x.dtype)


def _swiglu(x, w1, w3, w2):
    return (jax.nn.silu(x @ w1) * (x @ w3)) @ w2


def _short_conv(h, w):
    hp = jnp.pad(h, ((0, 0), (1, 1), (0, 0)))
    return hp[:, :-2] * w[0] + hp[:, 1:-1] * w[1] + hp[:, 2:] * w[2]


def _fourier(z):
    b, s, _ = z.shape
    zh = z.reshape(b, s, N_GROUPS, GROUP_DIM).astype(jnp.float32)
    f = jnp.fft.fft2(zh, axes=(1, 3), norm="ortho").real
    return f.reshape(b, s, BRANCH_W).astype(z.dtype)


def _spatial_gate(uv, g, bn, w_s, b_s):
    u, v = jnp.split(uv, 2, axis=-1)
    v = _layer_norm(v, g, bn)
    b, s, _ = v.shape
    vc = v.reshape(b, s // CHUNK, CHUNK, N_GROUPS, GROUP_DIM)
    mixed = jnp.einsum("hpq,bnqhc->bnphc", w_s, vc) + b_s.T[:, :, None]
    return u * mixed.reshape(b, s, BRANCH_W)


def _multiscale_pool(z, w_grp, scale):
    b, s, _ = z.shape
    zf = z.reshape(b, s, N_GROUPS, GROUP_DIM).astype(jnp.float32)
    csum = jnp.pad(jnp.cumsum(zf, axis=1), ((0, 0), (1, 0), (0, 0), (0, 0)))
    t = jnp.arange(s)
    outs = []
    for gi, win in enumerate(POOL_WINDOWS):
        half = win // 2
        hi = jnp.minimum(t + half, s)
        lo = jnp.maximum(t - half, 0)
        cg = csum[:, :, gi]
        tot = jnp.take(cg, hi, axis=1) - jnp.take(cg, lo, axis=1)
        mean = tot / (hi - lo).astype(jnp.float32)[:, None]
        outs.append(mean - zf[:, :, gi])
    pooled = jnp.stack(outs, axis=2).astype(z.dtype)
    mixed = jnp.einsum("bsgc,gcd->bsgd", pooled, w_grp)
    return mixed.reshape(b, s, BRANCH_W) * scale


def _token_mix(x, w_in, conv_w, sgu_ln_g, sgu_ln_b, sgu_w, sgu_b, pool_w, pool_scale,
               w_gate, b_gate, w_branch, w_out):
    z = x @ w_in
    h, gb, gc, zf, uv, zp = jnp.split(z, IN_SPLITS, axis=-1)
    branches = (
        gb * _short_conv(gc * h, conv_w),
        _fourier(zf),
        _spatial_gate(jax.nn.gelu(uv), sgu_ln_g, sgu_ln_b, sgu_w, sgu_b),
        _multiscale_pool(zp, pool_w, pool_scale),
    )
    merged = jnp.zeros_like(x)
    for i, br in enumerate(branches):
        gate = jax.nn.sigmoid(x @ w_gate[i] + b_gate[i])
        merged = merged + gate * (br @ w_branch[i])
    return merged @ w_out


def _trunk(x, ln_g, ln_b, ffn_w1, ffn_w3, ffn_w2, w_in, conv_w, sgu_ln_g, sgu_ln_b, sgu_w,
           sgu_b, pool_w, pool_scale, w_gate, b_gate, w_branch, w_out):
    for l in range(DEPTH):
        f1 = _swiglu(x, ffn_w1[l, 0], ffn_w3[l, 0], ffn_w2[l, 0])
        x = _layer_norm(ALPHA * x + 0.5 * f1, ln_g[l, 0], ln_b[l, 0])
        m = _token_mix(x, w_in[l], conv_w[l], sgu_ln_g[l], sgu_ln_b[l], sgu_w[l], sgu_b[l],
                       pool_w[l], pool_scale[l], w_gate[l], b_gate[l], w_branch[l], w_out[l])
        x = _layer_norm(ALPHA * x + m, ln_g[l, 1], ln_b[l, 1])
        f2 = _swiglu(x, ffn_w1[l, 1], ffn_w3[l, 1], ffn_w2[l, 1])
        x = _layer_norm(ALPHA * x + 0.5 * f2, ln_g[l, 2], ln_b[l, 2])
    return x


def setup_inputs(seed: int = 0) -> dict:
    key = jax.random.key(seed)
    ks = jax.random.split(key, 20)
    f32 = jnp.float32
    nrm = lambda k, shape, s: jax.random.normal(k, shape, f32) * s
    return {
        "x_prompt": nrm(ks[0], (BATCH, SEQ, D_MODEL), 1.0),
        "x_sample": nrm(ks[1], (DEC_BATCH, DEC_SEQ, D_MODEL), 1.0),
        "ln_g": 1.0 + nrm(ks[2], (DEPTH, 3, D_MODEL), 0.01),
        "ln_b": nrm(ks[3], (DEPTH, 3, D_MODEL), 0.01),
        "ffn_w1": nrm(ks[4], (DEPTH, 2, D_MODEL, D_FF), D_MODEL ** -0.5),
        "ffn_w3": nrm(ks[5], (DEPTH, 2, D_MODEL, D_FF), D_MODEL ** -0.5),
        "ffn_w2": nrm(ks[6], (DEPTH, 2, D_FF, D_MODEL), BETA * D_FF ** -0.5),
        "w_in": nrm(ks[7], (DEPTH, D_MODEL, IN_WIDTH), D_MODEL ** -0.5),
        "conv_w": nrm(ks[8], (DEPTH, CONV_WIDTH, BRANCH_W), CONV_WIDTH ** -0.5),
        "sgu_ln_g": 1.0 + nrm(ks[9], (DEPTH, BRANCH_W), 0.01),
        "sgu_ln_b": nrm(ks[10], (DEPTH, BRANCH_W), 0.01),
        "sgu_w": nrm(ks[11], (DEPTH, N_GROUPS, CHUNK, CHUNK), CHUNK ** -0.5),
        "sgu_b": 1.0 + nrm(ks[12], (DEPTH, N_GROUPS, CHUNK), 0.01),
        "pool_w": nrm(ks[13], (DEPTH, N_GROUPS, GROUP_DIM, GROUP_DIM), GROUP_DIM ** -0.5),
        "pool_scale": 1.0 + nrm(ks[14], (DEPTH, BRANCH_W), 0.01),
        "w_gate": nrm(ks[15], (DEPTH, N_BRANCH, D_MODEL, D_MODEL), D_MODEL ** -0.5),
        "b_gate": nrm(ks[16], (DEPTH, N_BRANCH, D_MODEL), 0.01),
        "w_branch": nrm(ks[17], (DEPTH, N_BRANCH, BRANCH_W, D_MODEL), BETA * BRANCH_W ** -0.5),
        "w_out": nrm(ks[18], (DEPTH, D_MODEL, D_MODEL), BETA * D_MODEL ** -0.5),
    }


def reference(x_prompt, x_sample, ln_g, ln_b, ffn_w1, ffn_w3, ffn_w2, w_in, conv_w, sgu_ln_g,
              sgu_ln_b, sgu_w, sgu_b, pool_w, pool_scale, w_gate, b_gate, w_branch, w_out):
    y_prompt = _trunk(x_prompt, ln_g, ln_b, ffn_w1, ffn_w3, ffn_w2, w_in, conv_w, sgu_ln_g,
                      sgu_ln_b, sgu_w, sgu_b, pool_w, pool_scale, w_gate, b_gate, w_branch, w_out)
    y_sample = _trunk(x_sample, ln_g, ln_b, ffn_w1, ffn_w3, ffn_w2, w_in, conv_w, sgu_ln_g,
                      sgu_ln_b, sgu_w, sgu_b, pool_w, pool_scale, w_gate, b_gate, w_branch, w_out)
    return (y_prompt, y_sample)
```

```cpp
#include <hip/hip_runtime.h>
#include <hip/hip_cooperative_groups.h>
#include <cstdio>
namespace cg = cooperative_groups;

#ifndef N_LAUNCH_PER_PHASE
#define N_LAUNCH_PER_PHASE 0
#endif

#define LAS __attribute__((address_space(3)))
typedef unsigned short bf16_t;
typedef short bf16x8 __attribute__((ext_vector_type(8)));
typedef float f32x4 __attribute__((ext_vector_type(4)));
typedef unsigned u32x4 __attribute__((ext_vector_type(4)));
typedef unsigned u32x2 __attribute__((ext_vector_type(2)));

constexpr int T = 81920, TP = 65536, D = 1024, DFF = 2816;
constexpr int NTHREADS = 512;
constexpr int LDS_BYTES = 147456;
constexpr int HTB = 16384;
constexpr float ALPHA = 1.41421356237309515f;
constexpr float LN_EPS = 1e-5f;

constexpr size_t MiB = 1ull << 20;
constexpr size_t WS_W = 1 * MiB;
constexpr size_t W_UP = 0;
constexpr size_t W_DN = 22 * MiB;
constexpr size_t W_IN = 33 * MiB;
constexpr size_t W_G = 36 * MiB;
constexpr size_t W_F = 44 * MiB;
constexpr size_t W_B = 45 * MiB;
constexpr size_t W_O = 47 * MiB;
constexpr size_t W_LAYER = 49 * MiB;
constexpr size_t WS_DFT4 = 99 * MiB;
constexpr size_t WS_DFT2 = 163 * MiB;
constexpr size_t WS_XB = 179 * MiB;
constexpr size_t WS_R = 339 * MiB;
constexpr size_t WS_H = WS_R;
constexpr size_t WS_Z = WS_R;
constexpr size_t WS_MRG = WS_R;
constexpr size_t WS_ZT = WS_R + 240 * MiB;
constexpr size_t WS_BR = WS_R + 320 * MiB;
constexpr size_t WS_SCR = WS_R + 480 * MiB;
constexpr size_t WS_END = 915 * MiB;
constexpr int NPHASE = 23;

struct Params { const float* in[19]; float* out; unsigned char* ws; int ph_lo, ph_hi; };

typedef __bf16 bf16x2_t __attribute__((ext_vector_type(2)));
typedef float f32x2_t __attribute__((ext_vector_type(2)));
__device__ __forceinline__ unsigned cvt_pk_bf16(float lo, float hi) { const f32x2_t v = {lo, hi}; return __builtin_bit_cast(unsigned, __builtin_convertvector(v, bf16x2_t)); }
__device__ __forceinline__ bf16_t f2bf(float f) { return (bf16_t)(cvt_pk_bf16(f, 0.f) & 0xffffu); }
__device__ __forceinline__ float bflo(unsigned w) { return __uint_as_float(w << 16); }
__device__ __forceinline__ float bfhi(unsigned w) { return __uint_as_float(w & 0xffff0000u); }
__device__ __forceinline__ float sigmoid_f(float x) { return __builtin_amdgcn_rcpf(1.0f + __expf(-x)); }
__device__ __forceinline__ float gelu_tanh(float x) { return x * sigmoid_f(1.5957691216057308f * (x + 0.044715f * x * x * x)); }
__device__ __forceinline__ float silu_f(float x) { return x * sigmoid_f(x); }
__device__ __forceinline__ float wave_sum(float v, int lane) {
#pragma unroll
    for (int o = 32; o >= 1; o >>= 1) v += __int_as_float(__builtin_amdgcn_ds_bpermute((lane ^ o) << 2, __float_as_int(v)));
    return v;
}

__device__ __forceinline__ int lds_byte(int r, int c) { const int st = (r >> 4) * 2 + (c >> 5), rr = r & 15, cc = c & 31, ob = rr * 64 + cc * 2; return st * 1024 + (ob ^ (((ob >> 9) & 1) << 5)); }
__device__ __forceinline__ void stage_rc(int b, int& R, int& C) { const int st = b / 1024, sb = b % 1024, swz = sb ^ (((sb >> 9) & 1) << 5); R = (st >> 1) * 16 + swz / 64; C = (st & 1) * 32 + (swz % 64) / 2; }
__device__ __forceinline__ int perm32(int rho) { const int n = rho >> 4, i = rho & 15; return 8 * (i >> 2) + 4 * n + (i & 3); }

__device__ __forceinline__ bool tile_order(int L, int nM, int nN, int& pm, int& pn) {
    const int nwg = nM * nN; if (L >= nwg) return false;
    int wgid = L; { const int q = nwg / 8, r = nwg % 8, xcd = wgid % 8, off = wgid / 8; wgid = (xcd < r ? xcd * (q + 1) : r * (q + 1) + (xcd - r) * q) + off; }
    const int nig = 8 * nN, gid = wgid / nig, fm = gid * 8, gsz = (nM - fm) < 8 ? (nM - fm) : 8;
    pm = fm + ((wgid % nig) % gsz); pn = (wgid % nig) / gsz; return true;
}

struct Lane { int tid, wid, lane, wr, wc, fr, fq, bid; };
__device__ __forceinline__ Lane get_lane() { Lane l; l.tid = threadIdx.x; asm volatile("" : "+v"(l.tid)); l.bid = blockIdx.x; asm volatile("" : "+s"(l.bid)); l.wid = l.tid >> 6; l.lane = l.tid & 63; l.wr = l.wid >> 2; l.wc = l.wid & 3; l.fr = l.lane & 15; l.fq = l.lane >> 4; return l; }

template <bool PERM>
__device__ __forceinline__ void gemm_tile(const Lane& L, LAS unsigned char* lds, const bf16_t* __restrict__ A, int lda, const bf16_t* __restrict__ B, int ldb, int nt, f32x4 (&acc)[2][2][4][2]) {
    const int tid = L.tid, wr = L.wr, wc = L.wc, fr = L.fr, fq = L.fq;
    unsigned voffA[2], voffB[2];
#pragma unroll
    for (int i = 0; i < 2; ++i) { int R, C; stage_rc(tid * 16 + i * 8192, R, C); const int Rb = PERM ? ((R & ~31) + perm32(R & 31)) : R; voffA[i] = (unsigned)(R * lda + C) * 2u; voffB[i] = (unsigned)(Rb * ldb + C) * 2u; }
    const unsigned ldsw = (unsigned)__builtin_amdgcn_readfirstlane(tid >> 6) * 1024u;
    const int aoff = lds_byte(wr * 64 + fr, fq * 8), boff = lds_byte(wc * 32 + fr, fq * 8);
    const char* Ab = (const char*)A; const char* Bb = (const char*)B; const size_t hA = (size_t)128 * lda * 2, hB = (size_t)128 * ldb * 2;
#define GT_STAGE(sb, t) do { _Pragma("unroll") for (int _h = 0; _h < 2; ++_h) { _Pragma("unroll") for (int _i = 0; _i < 2; ++_i) { \
        __builtin_amdgcn_global_load_lds((const unsigned*)(Ab + _h * hA + (size_t)(t) * 128 + voffA[_i]), (LAS unsigned*)(lds + (sb) * 65536 + _h * HTB + ldsw + _i * 8192), 16, 0, 0); \
        __builtin_amdgcn_global_load_lds((const unsigned*)(Bb + _h * hB + (size_t)(t) * 128 + voffB[_i]), (LAS unsigned*)(lds + (sb) * 65536 + (2 + _h) * HTB + ldsw + _i * 8192), 16, 0, 0); } } } while (0)
#pragma unroll
    for (int a = 0; a < 2; ++a)
#pragma unroll
        for (int b = 0; b < 2; ++b)
#pragma unroll
            for (int m = 0; m < 4; ++m)
#pragma unroll
                for (int n = 0; n < 2; ++n) acc[a][b][m][n] = (f32x4){0.f, 0.f, 0.f, 0.f};
    { int t0 = 0; asm volatile("" : "+s"(t0)); GT_STAGE(0, t0); }
    asm volatile("s_waitcnt vmcnt(0)" ::: "memory"); __syncthreads();
    for (int t = 0; t < nt; ++t) {
        const int sb = t & 1;
        if (t + 1 < nt) { int tn = t + 1; asm volatile("" : "+s"(tn)); GT_STAGE(sb ^ 1, tn); }
        LAS unsigned char* buf = lds + sb * 65536;
#pragma unroll
        for (int ai = 0; ai < 2; ++ai) {
            __builtin_amdgcn_sched_barrier(0);
            bf16x8 At[4][2];
#pragma unroll
            for (int m = 0; m < 4; ++m)
#pragma unroll
                for (int k = 0; k < 2; ++k) At[m][k] = *(const LAS bf16x8*)(buf + ai * HTB + aoff + m * 2048 + k * 1024);
#pragma unroll
            for (int bj = 0; bj < 2; ++bj) {
                __builtin_amdgcn_sched_barrier(0);
                bf16x8 Bf[2][2];
#pragma unroll
                for (int n = 0; n < 2; ++n)
#pragma unroll
                    for (int k = 0; k < 2; ++k) Bf[n][k] = *(const LAS bf16x8*)(buf + (2 + bj) * HTB + boff + n * 2048 + k * 1024);
#pragma unroll
                for (int m = 0; m < 4; ++m)
#pragma unroll
                    for (int n = 0; n < 2; ++n)
#pragma unroll
                        for (int k = 0; k < 2; ++k) acc[ai][bj][m][n] = __builtin_amdgcn_mfma_f32_16x16x32_bf16(Bf[n][k], At[m][k], acc[ai][bj][m][n], 0, 0, 0);
            }
        }
        asm volatile("s_waitcnt vmcnt(0)" ::: "memory"); __syncthreads();
    }
#undef GT_STAGE
}

__device__ __forceinline__ void transpose_job(const Lane& L, LAS float* tile, const float* __restrict__ src, int ld, int K, int N, bf16_t* __restrict__ dst, int dstld, int mapkind, int rowoff) {
    const int tn = N / 64, ntile = (K / 64) * tn;
    for (int tl = L.bid; tl < ntile; tl += gridDim.x) {
        const int k0 = (tl / tn) * 64, n0 = (tl % tn) * 64;
        __syncthreads();
        for (int e = L.tid; e < 4096; e += NTHREADS) { const int r = e >> 6, c = e & 63; tile[r * 65 + c] = src[(size_t)(k0 + r) * ld + n0 + c]; }
        __syncthreads();
        for (int e = L.tid; e < 4096; e += NTHREADS) { const int r = e >> 6, c = e & 63; const int n = n0 + r;
            const int drow = mapkind == 0 ? rowoff + n : ((n >> 7) * 256 + rowoff + (n & 127));
            dst[(size_t)drow * dstld + k0 + c] = f2bf(tile[c * 65 + r]); }
    }
}

__device__ __forceinline__ void phase_prep(const Params& p, LAS unsigned char* lds) {
    LAS float* tile = (LAS float*)lds;
    LAS float* ctab = (LAS float*)(lds + 32768);
    const Lane L = get_lane(); const int tid = L.tid;
    if (tid < 64) ctab[tid] = cospif((float)tid * (1.0f / 32.0f));
    __syncthreads();
    const size_t gtid = (size_t)L.bid * NTHREADS + tid, gsz = (size_t)gridDim.x * NTHREADS;
    for (int l = 0; l < 2; ++l) {
        unsigned char* wl = p.ws + WS_W + (size_t)l * W_LAYER;
        for (int f = 0; f < 2; ++f) {
            transpose_job(L, tile, p.in[4] + (size_t)(l * 2 + f) * D * DFF, DFF, D, DFF, (bf16_t*)(wl + W_UP) + (size_t)f * 5632 * 1024, 1024, 1, 0);
            transpose_job(L, tile, p.in[5] + (size_t)(l * 2 + f) * D * DFF, DFF, D, DFF, (bf16_t*)(wl + W_UP) + (size_t)f * 5632 * 1024, 1024, 1, 128);
            transpose_job(L, tile, p.in[6] + (size_t)(l * 2 + f) * DFF * D, D, DFF, D, (bf16_t*)(wl + W_DN) + (size_t)f * 1024 * DFF, DFF, 0, 0);
        }
        const float* win = p.in[7] + (size_t)l * D * 1792;
        transpose_job(L, tile, win, 1792, D, 768, (bf16_t*)(wl + W_IN), 1024, 0, 0);
        transpose_job(L, tile, win + 1024, 1792, D, 512, (bf16_t*)(wl + W_IN), 1024, 0, 768);
        for (int i = 0; i < 4; ++i) {
            transpose_job(L, tile, p.in[15] + (size_t)(l * 4 + i) * D * D, D, D, D, (bf16_t*)(wl + W_G), 1024, 0, i * 1024);
            transpose_job(L, tile, p.in[17] + (size_t)(l * 4 + i) * 256 * D, D, 256, D, (bf16_t*)(wl + W_B) + (size_t)i * 1024 * 256, 256, 0, 0);
        }
        transpose_job(L, tile, p.in[18] + (size_t)l * D * D, D, D, D, (bf16_t*)(wl + W_O), 1024, 0, 0);
        { const float* pw = p.in[13] + (size_t)l * 4 * 64 * 64; const float* psc = p.in[14] + (size_t)l * 256; bf16_t* dst = (bf16_t*)(wl + W_IN);
          for (size_t idx = gtid; idx < 256 * 1024; idx += gsz) { const int n = (int)(idx >> 10), d = (int)(idx & 1023), g = n >> 6, e = n & 63; float s = 0.f;
              const float* wr_ = win + (size_t)d * 1792 + 1536 + g * 64; const float* pg = pw + (size_t)g * 4096 + e;
              for (int c = 0; c < 64; ++c) s += wr_[c] * pg[c * 64];
              dst[(size_t)(1280 + n) * 1024 + d] = f2bf(s * psc[n]); } }
        { bf16_t* dst = (bf16_t*)(wl + W_F);
          for (size_t idx = gtid; idx < 512 * 1024; idx += gsz) { const int n = (int)(idx >> 10), d = (int)(idx & 1023), part = n >> 8, hh = (n >> 6) & 3, mm = n & 63; float s = 0.f;
              const float* wr_ = win + (size_t)d * 1792 + 768 + hh * 64; const int sh = part ? 16 : 0;
              for (int c = 0; c < 64; ++c) s += wr_[c] * ctab[((mm * c) - sh) & 63];
              dst[(size_t)n * 1024 + d] = f2bf(s); } }
    }
    { bf16_t* d4 = (bf16_t*)(p.ws + WS_DFT4);
      for (size_t idx = gtid; idx < (size_t)4096 * 1024; idx += gsz) { const int k = (int)(idx >> 10), c8 = (int)(idx & 1023) * 8; float v[8];
#pragma unroll
          for (int e = 0; e < 8; ++e) { const int col = c8 + e, s = col & 4095, j = (k * s) & 4095; const float x = (float)j * (1.0f / 2048.0f); v[e] = (col >> 12) ? -sinpif(x) : cospif(x); }
          u32x4 w; w.x = cvt_pk_bf16(v[0], v[1]); w.y = cvt_pk_bf16(v[2], v[3]); w.z = cvt_pk_bf16(v[4], v[5]); w.w = cvt_pk_bf16(v[6], v[7]);
          *(u32x4*)(d4 + (size_t)k * 8192 + c8) = w; }
      bf16_t* d2 = (bf16_t*)(p.ws + WS_DFT2);
      for (size_t idx = gtid; idx < (size_t)2048 * 512; idx += gsz) { const int k = (int)(idx >> 9), c8 = (int)(idx & 511) * 8; float v[8];
#pragma unroll
          for (int e = 0; e < 8; ++e) { const int col = c8 + e, s = col & 2047, j = (k * s) & 2047; const float x = (float)j * (1.0f / 1024.0f); v[e] = (col >> 11) ? -sinpif(x) : cospif(x); }
          u32x4 w; w.x = cvt_pk_bf16(v[0], v[1]); w.y = cvt_pk_bf16(v[2], v[3]); w.z = cvt_pk_bf16(v[4], v[5]); w.w = cvt_pk_bf16(v[6], v[7]);
          *(u32x4*)(d2 + (size_t)k * 4096 + c8) = w; } }
    { const f32x4* xp = (const f32x4*)p.in[0]; const f32x4* xs = (const f32x4*)p.in[1]; f32x4* xo = (f32x4*)p.out; u32x2* xb = (u32x2*)(p.ws + WS_XB);
      for (size_t idx = gtid; idx < (size_t)T * 256; idx += gsz) { const f32x4 v = idx < (size_t)TP * 256 ? xp[idx] : xs[idx - (size_t)TP * 256]; xo[idx] = v;
          u32x2 w; w.x = cvt_pk_bf16(v[0], v[1]); w.y = cvt_pk_bf16(v[2], v[3]); xb[idx] = w; } }
}

__device__ __forceinline__ void phase_ln(const Params& p, int l, int which) {
    const Lane L = get_lane();
    const float* g = p.in[2] + (size_t)(l * 3 + which) * 1024; const float* b = p.in[3] + (size_t)(l * 3 + which) * 1024;
    f32x4 gv[4], bv[4];
#pragma unroll
    for (int j = 0; j < 4; ++j) { gv[j] = *(const f32x4*)(g + j * 256 + L.lane * 4); bv[j] = *(const f32x4*)(b + j * 256 + L.lane * 4); }
    bf16_t* xb = (bf16_t*)(p.ws + WS_XB);
    for (int row = L.bid * 8 + L.wid; row < T; row += gridDim.x * 8) {
        float* rp = p.out + (size_t)row * 1024 + L.lane * 4; f32x4 v[4]; float s = 0.f;
#pragma unroll
        for (int j = 0; j < 4; ++j) { v[j] = *(const f32x4*)(rp + j * 256); s += (v[j][0] + v[j][1]) + (v[j][2] + v[j][3]); }
        const float mean = wave_sum(s, L.lane) * (1.0f / 1024.0f); float q = 0.f;
#pragma unroll
        for (int j = 0; j < 4; ++j) { const f32x4 d = v[j] - mean; q += (d[0] * d[0] + d[1] * d[1]) + (d[2] * d[2] + d[3] * d[3]); }
        const float rstd = rsqrtf(wave_sum(q, L.lane) * (1.0f / 1024.0f) + LN_EPS);
#pragma unroll
        for (int j = 0; j < 4; ++j) { const f32x4 o = (v[j] - mean) * rstd * gv[j] + bv[j]; *(f32x4*)(rp + j * 256) = o;
            u32x2 w; w.x = cvt_pk_bf16(o[0], o[1]); w.y = cvt_pk_bf16(o[2], o[3]); *(u32x2*)(xb + (size_t)row * 1024 + j * 256 + L.lane * 4) = w; }
    }
}

__device__ __forceinline__ u32x4 pack8(const f32x4& a, const f32x4& b) { u32x4 w; w.x = cvt_pk_bf16(a[0], a[1]); w.y = cvt_pk_bf16(a[2], a[3]); w.z = cvt_pk_bf16(b[0], b[1]); w.w = cvt_pk_bf16(b[2], b[3]); return w; }

__device__ __forceinline__ void phase_ffn_up(const Params& p, LAS unsigned char* lds, int l, int f) {
    const Lane L = get_lane(); f32x4 acc[2][2][4][2];
    const bf16_t* xb = (const bf16_t*)(p.ws + WS_XB); const bf16_t* W = (const bf16_t*)(p.ws + WS_W + (size_t)l * W_LAYER + W_UP) + (size_t)f * 5632 * 1024; bf16_t* H = (bf16_t*)(p.ws + WS_H);
    for (int i = 0;; ++i) { int pm, pn; if (!tile_order(i * gridDim.x + L.bid, 320, 22, pm, pn)) break;
        gemm_tile<true>(L, lds, xb + (size_t)pm * 256 * 1024, 1024, W + (size_t)pn * 256 * 1024, 1024, 16, acc);
        const int row0 = pm * 256 + L.wr * 64 + L.fr, col0 = pn * 128 + L.wc * 32 + 8 * L.fq;
#pragma unroll
        for (int ai = 0; ai < 2; ++ai)
#pragma unroll
            for (int m = 0; m < 4; ++m) { f32x4 o[2];
#pragma unroll
                for (int n = 0; n < 2; ++n)
#pragma unroll
                    for (int j = 0; j < 4; ++j) o[n][j] = silu_f(acc[ai][0][m][n][j]) * acc[ai][1][m][n][j];
                *(u32x4*)(H + (size_t)(row0 + ai * 128 + m * 16) * DFF + col0) = pack8(o[0], o[1]); }
    }
}

__device__ __forceinline__ void phase_down(const Params& p, LAS unsigned char* lds, const bf16_t* A, int K, const bf16_t* W, float cscale) {
    const Lane L = get_lane(); f32x4 acc[2][2][4][2];
    for (int i = 0;; ++i) { int pm, pn; if (!tile_order(i * gridDim.x + L.bid, 320, 4, pm, pn)) break;
        gemm_tile<false>(L, lds, A + (size_t)pm * 256 * K, K, W + (size_t)pn * 256 * K, K, K / 64, acc);
        const int row0 = pm * 256 + L.wr * 64 + L.fr, col0 = pn * 256 + L.wc * 32 + 4 * L.fq;
#pragma unroll
        for (int ai = 0; ai < 2; ++ai)
#pragma unroll
            for (int m = 0; m < 4; ++m) { float* rp = p.out + (size_t)(row0 + ai * 128 + m * 16) * 1024 + col0;
#pragma unroll
                for (int bj = 0; bj < 2; ++bj)
#pragma unroll
                    for (int n = 0; n < 2; ++n) { const f32x4 x = *(const f32x4*)(rp + bj * 128 + n * 16); *(f32x4*)(rp + bj * 128 + n * 16) = x * ALPHA + acc[ai][bj][m][n] * cscale; }
                asm volatile("" ::: "memory"); }
    }
}

__device__ __forceinline__ void phase_mix_in(const Params& p, LAS unsigned char* lds, int l) {
    const Lane L = get_lane(); f32x4 acc[2][2][4][2];
    const bf16_t* xb = (const bf16_t*)(p.ws + WS_XB); const unsigned char* wl = p.ws + WS_W + (size_t)l * W_LAYER;
    const bf16_t* Win = (const bf16_t*)(wl + W_IN); const bf16_t* Wf = (const bf16_t*)(wl + W_F);
    bf16_t* Z = (bf16_t*)(p.ws + WS_Z); bf16_t* ZT = (bf16_t*)(p.ws + WS_ZT);
    for (int i = 0;; ++i) { int pm, pn; if (!tile_order(i * gridDim.x + L.bid, 320, 6, pm, pn)) break;
        gemm_tile<true>(L, lds, xb + (size_t)pm * 256 * 1024, 1024, Win + (size_t)pn * 256 * 1024, 1024, 16, acc);
        const int row0 = pm * 256 + L.wr * 64 + L.fr, col0 = pn * 256 + L.wc * 32 + 8 * L.fq; const bool act = (pn == 3 || pn == 4);
#pragma unroll
        for (int ai = 0; ai < 2; ++ai)
#pragma unroll
            for (int m = 0; m < 4; ++m)
#pragma unroll
                for (int bj = 0; bj < 2; ++bj) { f32x4 o0 = acc[ai][bj][m][0], o1 = acc[ai][bj][m][1];
                    if (act) {
#pragma unroll
                        for (int j = 0; j < 4; ++j) { o0[j] = gelu_tanh(o0[j]); o1[j] = gelu_tanh(o1[j]); } }
                    *(u32x4*)(Z + (size_t)(row0 + ai * 128 + m * 16) * 1536 + col0 + bj * 128) = pack8(o0, o1); }
    }
    for (int i = 0;; ++i) { int pn, pm; if (!tile_order(i * gridDim.x + L.bid, 320, 2, pn, pm)) break;
        gemm_tile<true>(L, lds, Wf + (size_t)pm * 256 * 1024, 1024, xb + (size_t)pn * 256 * 1024, 1024, 16, acc);
        const int tok0 = pn * 256;
        size_t base; int S;
        if (tok0 < TP) { S = 4096; base = (size_t)(tok0 >> 12) * 256 * 2 * 4096 + (tok0 & 4095); }
        else { S = 2048; const int t2 = tok0 - TP; base = (size_t)TP * 512 + (size_t)(t2 >> 11) * 256 * 2 * 2048 + (t2 & 2047); }
#pragma unroll
        for (int ai = 0; ai < 2; ++ai)
#pragma unroll
            for (int m = 0; m < 4; ++m) { const int colc = ai * 128 + L.wr * 64 + m * 16 + L.fr;
#pragma unroll
                for (int bj = 0; bj < 2; ++bj)
                    *(u32x4*)(ZT + base + (size_t)(colc * 2 + pm) * S + bj * 128 + L.wc * 32 + 8 * L.fq) = pack8(acc[ai][bj][m][0], acc[ai][bj][m][1]); }
    }
}

__device__ __forceinline__ void phase_dft(const Params& p, LAS unsigned char* lds) {
    const Lane L = get_lane(); f32x4 acc[2][2][4][2];
    const bf16_t* ZT = (const bf16_t*)(p.ws + WS_ZT); bf16_t* BR1 = (bf16_t*)(p.ws + WS_BR) + (size_t)1 * T * 256;
    for (int u = L.bid; u < 320; u += gridDim.x) {
        const bf16_t* A; const bf16_t* B; int K, tok0; float scale;
        if (u < 256) { const int b = u >> 4, pm = u & 15; K = 8192; A = (const bf16_t*)(p.ws + WS_DFT4) + (size_t)pm * 256 * 8192; B = ZT + (size_t)b * 256 * 8192; tok0 = b * 4096 + pm * 256; scale = 1.0f / 512.0f; }
        else { const int v = u - 256, b = v >> 3, pm = v & 7; K = 4096; A = (const bf16_t*)(p.ws + WS_DFT2) + (size_t)pm * 256 * 4096; B = ZT + (size_t)TP * 512 + (size_t)b * 256 * 4096; tok0 = TP + b * 2048 + pm * 256; scale = 0.00276213586400995f; }
        gemm_tile<true>(L, lds, A, K, B, K, K / 64, acc);
        const int row0 = tok0 + L.wr * 64 + L.fr, col0 = L.wc * 32 + 8 * L.fq;
#pragma unroll
        for (int ai = 0; ai < 2; ++ai)
#pragma unroll
            for (int m = 0; m < 4; ++m)
#pragma unroll
                for (int bj = 0; bj < 2; ++bj)
                    *(u32x4*)(BR1 + (size_t)(row0 + ai * 128 + m * 16) * 256 + col0 + bj * 128) = pack8(acc[ai][bj][m][0] * scale, acc[ai][bj][m][1] * scale);
    }
}

__device__ __forceinline__ void phase_mixers(const Params& p, LAS unsigned char* lds, int l) {
    const Lane L = get_lane(); const int tid = L.tid;
    const bf16_t* Z = (const bf16_t*)(p.ws + WS_Z);
    bf16_t* BR0 = (bf16_t*)(p.ws + WS_BR); bf16_t* BR2 = BR0 + (size_t)2 * T * 256; bf16_t* BR3 = BR0 + (size_t)3 * T * 256;
    const size_t gtid = (size_t)L.bid * NTHREADS + tid, gsz = (size_t)gridDim.x * NTHREADS;
    const float* cw = p.in[8] + (size_t)l * 3 * 256;
    for (size_t idx = gtid; idx < (size_t)T * 32; idx += gsz) {
        const int t = (int)(idx >> 5), c8 = (int)(idx & 31) * 8; int s, S; if (t < TP) { s = t & 4095; S = 4096; } else { s = (t - TP) & 2047; S = 2048; }
        const bf16_t* zr = Z + (size_t)t * 1536 + c8;
        { const u32x4 hv = *(const u32x4*)zr, gb = *(const u32x4*)(zr + 256), gc = *(const u32x4*)(zr + 512);
          u32x4 hp = (u32x4){0u, 0u, 0u, 0u}, cp = hp, hn = hp, cn = hp;
          if (s > 0) { hp = *(const u32x4*)(zr - 1536); cp = *(const u32x4*)(zr - 1536 + 512); }
          if (s + 1 < S) { hn = *(const u32x4*)(zr + 1536); cn = *(const u32x4*)(zr + 1536 + 512); }
          const f32x4 w0a = *(const f32x4*)(cw + c8), w0b = *(const f32x4*)(cw + c8 + 4), w1a = *(const f32x4*)(cw + 256 + c8), w1b = *(const f32x4*)(cw + 256 + c8 + 4), w2a = *(const f32x4*)(cw + 512 + c8), w2b = *(const f32x4*)(cw + 512 + c8 + 4);
          float o[8];
#pragma unroll
          for (int e = 0; e < 4; ++e) {
              const float k0l = e < 2 ? w0a[2 * e] : w0b[2 * e - 4], k0h = e < 2 ? w0a[2 * e + 1] : w0b[2 * e - 3];
              const float k1l = e < 2 ? w1a[2 * e] : w1b[2 * e - 4], k1h = e < 2 ? w1a[2 * e + 1] : w1b[2 * e - 3];
              const float k2l = e < 2 ? w2a[2 * e] : w2b[2 * e - 4], k2h = e < 2 ? w2a[2 * e + 1] : w2b[2 * e - 3];
              o[2 * e] = bflo(gb[e]) * (k0l * bflo(cp[e]) * bflo(hp[e]) + k1l * bflo(gc[e]) * bflo(hv[e]) + k2l * bflo(cn[e]) * bflo(hn[e]));
              o[2 * e + 1] = bfhi(gb[e]) * (k0h * bfhi(cp[e]) * bfhi(hp[e]) + k1h * bfhi(gc[e]) * bfhi(hv[e]) + k2h * bfhi(cn[e]) * bfhi(hn[e])); }
          u32x4 w; w.x = cvt_pk_bf16(o[0], o[1]); w.y = cvt_pk_bf16(o[2], o[3]); w.z = cvt_pk_bf16(o[4], o[5]); w.w = cvt_pk_bf16(o[6], o[7]);
          *(u32x4*)(BR0 + (size_t)t * 256 + c8) = w; }
        { const int half = 1 << (c8 >> 6); const int lo = s - half < 0 ? 0 : s - half, hi = s + half > S ? S : s + half;
          float sum[8];
#pragma unroll
          for (int e = 0; e < 8; ++e) sum[e] = 0.f;
          for (int j = lo; j < hi; ++j) { const u32x4 v = *(const u32x4*)(zr + 1280 + (ptrdiff_t)(j - s) * 1536);
#pragma unroll
              for (int e = 0; e < 4; ++e) { sum[2 * e] += bflo(v[e]); sum[2 * e + 1] += bfhi(v[e]); } }
          const float inv = 1.0f / (float)(hi - lo); const u32x4 zc = *(const u32x4*)(zr + 1280);
          u32x4 w;
#pragma unroll
          for (int e = 0; e < 4; ++e) w[e] = cvt_pk_bf16(sum[2 * e] * inv - bflo(zc[e]), sum[2 * e + 1] * inv - bfhi(zc[e]));
          *(u32x4*)(BR3 + (size_t)t * 256 + c8) = w; }
    }
    LAS bf16_t* VT = (LAS bf16_t*)lds;
    LAS float* red = (LAS float*)(lds + 69632);
    const float* lg = p.in[9] + (size_t)l * 256; const float* lb = p.in[10] + (size_t)l * 256;
    const float* sw = p.in[11] + (size_t)l * 4 * 128 * 128; const float* sb = p.in[12] + (size_t)l * 4 * 128;
    for (int ch = L.bid; ch < T / 128; ch += gridDim.x) {
        const int t0 = ch * 128, q = tid & 127, part = tid >> 7;
        const bf16_t* vp = Z + (size_t)(t0 + q) * 1536 + 1024 + part * 64;
        __syncthreads();
        float s = 0.f, ss = 0.f;
#pragma unroll
        for (int j = 0; j < 8; ++j) { const u32x4 w = *(const u32x4*)(vp + j * 8);
#pragma unroll
            for (int e = 0; e < 4; ++e) { const float a = bflo(w[e]), b = bfhi(w[e]); s += a + b; ss += a * a + b * b; } }
        red[(part * 128 + q) * 2] = s; red[(part * 128 + q) * 2 + 1] = ss;
        __syncthreads();
        float S1 = 0.f, S2 = 0.f;
#pragma unroll
        for (int pp = 0; pp < 4; ++pp) { S1 += red[(pp * 128 + q) * 2]; S2 += red[(pp * 128 + q) * 2 + 1]; }
        const float mean = S1 * (1.0f / 256.0f), var = S2 * (1.0f / 256.0f) - mean * mean, rstd = rsqrtf((var > 0.f ? var : 0.f) + LN_EPS);
#pragma unroll
        for (int j = 0; j < 8; ++j) { const u32x4 w = *(const u32x4*)(vp + j * 8); const int c0 = part * 64 + j * 8;
#pragma unroll
            for (int e = 0; e < 4; ++e) { const float a = (bflo(w[e]) - mean) * rstd * lg[c0 + 2 * e] + lb[c0 + 2 * e], b = (bfhi(w[e]) - mean) * rstd * lg[c0 + 2 * e + 1] + lb[c0 + 2 * e + 1];
                VT[(c0 + 2 * e) * 136 + q] = f2bf(a); VT[(c0 + 2 * e + 1) * 136 + q] = f2bf(b); } }
        __syncthreads();
        const int hh = L.wid >> 1, ph = L.wid & 1;
        f32x4 a2[4][4];
#pragma unroll
        for (int ct = 0; ct < 4; ++ct)
#pragma unroll
            for (int pt = 0; pt < 4; ++pt) a2[ct][pt] = (f32x4){0.f, 0.f, 0.f, 0.f};
#pragma unroll
        for (int ks = 0; ks < 4; ++ks) {
            bf16x8 wf[4];
#pragma unroll
            for (int pt = 0; pt < 4; ++pt) { const float* wp = sw + ((size_t)(hh * 128 + ph * 64 + pt * 16 + L.fr) * 128 + ks * 32 + L.fq * 8);
                const f32x4 w0 = *(const f32x4*)wp, w1 = *(const f32x4*)(wp + 4); wf[pt] = __builtin_bit_cast(bf16x8, pack8(w0, w1)); }
#pragma unroll
            for (int ct = 0; ct < 4; ++ct) { const bf16x8 vf = *(const LAS bf16x8*)(VT + (hh * 64 + ct * 16 + L.fr) * 136 + ks * 32 + L.fq * 8);
#pragma unroll
                for (int pt = 0; pt < 4; ++pt) a2[ct][pt] = __builtin_amdgcn_mfma_f32_16x16x32_bf16(vf, wf[pt], a2[ct][pt], 0, 0, 0); }
        }
#pragma unroll
        for (int pt = 0; pt < 4; ++pt) { const int pp = ph * 64 + pt * 16 + L.fr, t = t0 + pp; const float bias = sb[hh * 128 + pp];
#pragma unroll
            for (int ct = 0; ct < 4; ++ct) { const int c = hh * 64 + ct * 16 + 4 * L.fq; const u32x2 u = *(const u32x2*)(Z + (size_t)t * 1536 + 768 + c);
                u32x2 w; w.x = cvt_pk_bf16(bflo(u.x) * (a2[ct][pt][0] + bias), bfhi(u.x) * (a2[ct][pt][1] + bias)); w.y = cvt_pk_bf16(bflo(u.y) * (a2[ct][pt][2] + bias), bfhi(u.y) * (a2[ct][pt][3] + bias));
                *(u32x2*)(BR2 + (size_t)t * 256 + c) = w; } }
    }
}

__device__ __forceinline__ void phase_gate_branch(const Params& p, LAS unsigned char* lds, int l) {
    const Lane L = get_lane(); f32x4 acc[2][2][4][2];
    const bf16_t* xb = (const bf16_t*)(p.ws + WS_XB); const unsigned char* wl = p.ws + WS_W + (size_t)l * W_LAYER;
    const bf16_t* Wg = (const bf16_t*)(wl + W_G); const bf16_t* Wb = (const bf16_t*)(wl + W_B); const bf16_t* BR = (const bf16_t*)(p.ws + WS_BR);
    const float* bg = p.in[16] + (size_t)l * 4 * 1024; bf16_t* MRG = (bf16_t*)(p.ws + WS_MRG);
    unsigned char* scr = p.ws + WS_SCR + (size_t)L.bid * 393216;
    for (int it = 0;; ++it) { int pm, pn; if (!tile_order(it * gridDim.x + L.bid, 320, 4, pm, pn)) break;
        const int row0 = pm * 256 + L.wr * 64 + L.fr, col0 = pn * 256 + L.wc * 32 + 8 * L.fq;
#pragma unroll 1
        for (int i = 0; i < 4; ++i) {
            gemm_tile<true>(L, lds, xb + (size_t)pm * 256 * 1024, 1024, Wg + (size_t)(i * 1024 + pn * 256) * 1024, 1024, 16, acc);
            unsigned loff = (unsigned)L.tid * 16u; asm volatile("" : "+v"(loff));
#pragma unroll
            for (int bj = 0; bj < 2; ++bj) { const f32x4 b0 = *(const f32x4*)(bg + i * 1024 + col0 + bj * 128), b1 = *(const f32x4*)(bg + i * 1024 + col0 + bj * 128 + 4);
#pragma unroll
                for (int ai = 0; ai < 2; ++ai)
#pragma unroll
                    for (int m = 0; m < 4; ++m) { f32x4 g0 = acc[ai][bj][m][0] + b0, g1 = acc[ai][bj][m][1] + b1;
#pragma unroll
                        for (int j = 0; j < 4; ++j) { g0[j] = sigmoid_f(g0[j]); g1[j] = sigmoid_f(g1[j]); }
                        *(u32x4*)(scr + (loff + (unsigned)(((ai * 2 + bj) * 4 + m) * 8192))) = pack8(g0, g1); asm volatile("" ::: "memory"); __builtin_amdgcn_sched_barrier(0); } }
            gemm_tile<true>(L, lds, BR + ((size_t)i * T + (size_t)pm * 256) * 256, 256, Wb + ((size_t)i * 1024 + pn * 256) * 256, 256, 4, acc);
            int row0o = row0; asm volatile("" : "+v"(row0o));
#pragma unroll
            for (int ai = 0; ai < 2; ++ai)
#pragma unroll
                for (int bj = 0; bj < 2; ++bj)
#pragma unroll
                    for (int m = 0; m < 4; ++m) { const int slot = (ai * 2 + bj) * 4 + m; const u32x4 g = *(const u32x4*)(scr + (loff + (unsigned)(slot * 8192)));
                        f32x4 v0 = acc[ai][bj][m][0] * (f32x4){bflo(g.x), bfhi(g.x), bflo(g.y), bfhi(g.y)}, v1 = acc[ai][bj][m][1] * (f32x4){bflo(g.z), bfhi(g.z), bflo(g.w), bfhi(g.w)};
                        if (i > 0) { v0 += *(const f32x4*)(scr + (loff + (unsigned)(131072 + (slot * 2) * 8192))); v1 += *(const f32x4*)(scr + (loff + (unsigned)(131072 + (slot * 2 + 1) * 8192))); }
                        if (i < 3) { *(f32x4*)(scr + (loff + (unsigned)(131072 + (slot * 2) * 8192))) = v0; *(f32x4*)(scr + (loff + (unsigned)(131072 + (slot * 2 + 1) * 8192))) = v1; }
                        else *(u32x4*)(MRG + (size_t)(row0o + ai * 128 + m * 16) * 1024 + col0 + bj * 128) = pack8(v0, v1);
                        asm volatile("" ::: "memory"); __builtin_amdgcn_sched_barrier(0); }
        }
    }
}

__global__ void __launch_bounds__(NTHREADS, 2) fwd_kernel(Params p) {
    extern __shared__ __attribute__((aligned(16))) unsigned char lds_raw[];
    LAS unsigned char* lds = (LAS unsigned char*)lds_raw;
    cg::grid_group grid = cg::this_grid();
    for (int ph = p.ph_lo; ph < p.ph_hi; ++ph) {
        if (ph > p.ph_lo) grid.sync();
        if (ph == 0) { phase_prep(p, lds); continue; }
        const int l = (ph - 1) / 11, s = (ph - 1) % 11;
        const unsigned char* wl = p.ws + WS_W + (size_t)l * W_LAYER;
        if (s == 0 || s == 8) phase_ffn_up(p, lds, l, s == 0 ? 0 : 1);
        else if (s == 1 || s == 9) phase_down(p, lds, (const bf16_t*)(p.ws + WS_H), DFF, (const bf16_t*)(wl + W_DN) + (size_t)(s == 1 ? 0 : 1) * 1024 * DFF, 0.5f);
        else if (s == 2 || s == 7 || s == 10) phase_ln(p, l, s == 2 ? 0 : (s == 7 ? 1 : 2));
        else if (s == 3) phase_mix_in(p, lds, l);
        else if (s == 4) { phase_dft(p, lds); __syncthreads(); phase_mixers(p, lds, l); }
        else if (s == 5) phase_gate_branch(p, lds, l);
        else if (s == 6) phase_down(p, lds, (const bf16_t*)(p.ws + WS_MRG), 1024, (const bf16_t*)(wl + W_O), 1.0f);
        __syncthreads();
    }
}

extern "C" void kernel_launch(void* const* d_in, const int* in_sizes, int n_in, void* d_out, int out_size, void* d_ws, size_t ws_size, hipStream_t stream) {
    static int grid = 0;
    if (grid == 0) {
        if (n_in != 19 || out_size != T * D || ws_size < WS_END) { fprintf(stderr, "kernel_launch: unexpected shapes (n_in %d, out %d, ws %zu)\n", n_in, out_size, ws_size); grid = -1; return; }
        int dev = 0, cus = 0, per_cu = 0;
        hipGetDevice(&dev); hipDeviceGetAttribute(&cus, hipDeviceAttributeMultiprocessorCount, dev);
        if (hipFuncSetAttribute((const void*)fwd_kernel, hipFuncAttributeMaxDynamicSharedMemorySize, LDS_BYTES) != hipSuccess) { fprintf(stderr, "kernel_launch: hipFuncSetAttribute failed\n"); grid = -1; return; }
        if (hipOccupancyMaxActiveBlocksPerMultiprocessor(&per_cu, (const void*)fwd_kernel, NTHREADS, LDS_BYTES) != hipSuccess || per_cu < 1) { fprintf(stderr, "kernel_launch: occupancy query says %d\n", per_cu); per_cu = 1; }
        (void)hipGetLastError();
        grid = cus * 1;
        fprintf(stderr, "kernel_launch: grid %d (cus %d, per_cu %d), ws %zu\n", grid, cus, per_cu, ws_size);
    }
    if (grid < 0) return;
    Params p{};
    for (int i = 0; i < 19; ++i) p.in[i] = (const float*)d_in[i];
    p.out = (float*)d_out; p.ws = (unsigned char*)d_ws;
#if N_LAUNCH_PER_PHASE
    for (int ph = 0; ph < NPHASE; ++ph) { p.ph_lo = ph; p.ph_hi = ph + 1; hipLaunchKernelGGL(fwd_kernel, dim3(grid), dim3(NTHREADS), LDS_BYTES, stream, p); }
#else
    p.ph_lo = 0; p.ph_hi = NPHASE;
    void* args[] = {&p};
    hipError_t e = hipLaunchCooperativeKernel((const void*)fwd_kernel, dim3(grid), dim3(NTHREADS), args, LDS_BYTES, stream);
    if (e != hipSuccess) fprintf(stderr, "cooperative launch failed: %s (grid %d)\n", hipGetErrorString(e), grid);
#endif
}
```

```cpp
#include <hip/hip_runtime.h>
#include <hip/hip_cooperative_groups.h>
#include <cstdio>
namespace cg = cooperative_groups;

#ifndef N_LAUNCH_PER_PHASE
#define N_LAUNCH_PER_PHASE 0
#endif

#define LAS __attribute__((address_space(3)))
typedef unsigned short bf16_t;
typedef short bf16x8 __attribute__((ext_vector_type(8)));
typedef float f32x4 __attribute__((ext_vector_type(4)));
typedef unsigned u32x4 __attribute__((ext_vector_type(4)));
typedef unsigned u32x2 __attribute__((ext_vector_type(2)));

constexpr int T = 81920, TP = 65536, D = 1024, DFF = 2816;
constexpr int NTHREADS = 512;
constexpr int LDS_BYTES = 147456;
constexpr int HTB = 16384;
constexpr float ALPHA = 1.41421356237309515f;
constexpr float LN_EPS = 1e-5f;

constexpr size_t MiB = 1ull << 20;
constexpr size_t WS_W = 1 * MiB;
constexpr size_t W_UP = 0;
constexpr size_t W_DN = 22 * MiB;
constexpr size_t W_IN = 33 * MiB;
constexpr size_t W_G = 36 * MiB;
constexpr size_t W_F = 44 * MiB;
constexpr size_t W_B = 45 * MiB;
constexpr size_t W_O = 47 * MiB;
constexpr size_t W_LAYER = 49 * MiB;
constexpr size_t WS_DFT4 = 99 * MiB;
constexpr size_t WS_DFT2 = 163 * MiB;
constexpr size_t WS_XB = 179 * MiB;
constexpr size_t WS_R = 339 * MiB;
constexpr size_t WS_H = WS_R;
constexpr size_t WS_Z = WS_R;
constexpr size_t WS_MRG = WS_R;
constexpr size_t WS_ZT = WS_R + 240 * MiB;
constexpr size_t WS_BR = WS_R + 320 * MiB;
constexpr size_t WS_SCR = WS_R + 480 * MiB;
constexpr size_t WS_END = 915 * MiB;
constexpr int NPHASE = 23;

struct Params { const float* in[19]; float* out; unsigned char* ws; int ph_lo, ph_hi; };

typedef __bf16 bf16x2_t __attribute__((ext_vector_type(2)));
typedef float f32x2_t __attribute__((ext_vector_type(2)));
__device__ __forceinline__ unsigned cvt_pk_bf16(float lo, float hi) { const f32x2_t v = {lo, hi}; return __builtin_bit_cast(unsigned, __builtin_convertvector(v, bf16x2_t)); }
__device__ __forceinline__ bf16_t f2bf(float f) { return (bf16_t)(cvt_pk_bf16(f, 0.f) & 0xffffu); }
__device__ __forceinline__ float bflo(unsigned w) { return __uint_as_float(w << 16); }
__device__ __forceinline__ float bfhi(unsigned w) { return __uint_as_float(w & 0xffff0000u); }
__device__ __forceinline__ float sigmoid_f(float x) { return __builtin_amdgcn_rcpf(1.0f + __expf(-x)); }
__device__ __forceinline__ float gelu_tanh(float x) { return x * sigmoid_f(1.5957691216057308f * (x + 0.044715f * x * x * x)); }
__device__ __forceinline__ float silu_f(float x) { return x * sigmoid_f(x); }
__device__ __forceinline__ float wave_sum(float v, int lane) {
#pragma unroll
    for (int o = 32; o >= 1; o >>= 1) v += __int_as_float(__builtin_amdgcn_ds_bpermute((lane ^ o) << 2, __float_as_int(v)));
    return v;
}

__device__ __forceinline__ int lds_byte(int r, int c) { const int st = (r >> 4) * 2 + (c >> 5), rr = r & 15, cc = c & 31, ob = rr * 64 + cc * 2; return st * 1024 + (ob ^ (((ob >> 9) & 1) << 5)); }
__device__ __forceinline__ void stage_rc(int b, int& R, int& C) { const int st = b / 1024, sb = b % 1024, swz = sb ^ (((sb >> 9) & 1) << 5); R = (st >> 1) * 16 + swz / 64; C = (st & 1) * 32 + (swz % 64) / 2; }
__device__ __forceinline__ int perm32(int rho) { const int n = rho >> 4, i = rho & 15; return 8 * (i >> 2) + 4 * n + (i & 3); }

__device__ __forceinline__ bool tile_order(int L, int nM, int nN, int& pm, int& pn) {
    const int nwg = nM * nN; if (L >= nwg) return false;
    int wgid = L; { const int q = nwg / 8, r = nwg % 8, xcd = wgid % 8, off = wgid / 8; wgid = (xcd < r ? xcd * (q + 1) : r * (q + 1) + (xcd - r) * q) + off; }
    const int nig = 8 * nN, gid = wgid / nig, fm = gid * 8, gsz = (nM - fm) < 8 ? (nM - fm) : 8;
    pm = fm + ((wgid % nig) % gsz); pn = (wgid % nig) / gsz; return true;
}

struct Lane { int tid, wid, lane, wr, wc, fr, fq, bid; };
__device__ __forceinline__ Lane get_lane() { Lane l; l.tid = threadIdx.x; asm volatile("" : "+v"(l.tid)); l.bid = blockIdx.x; asm volatile("" : "+s"(l.bid)); l.wid = l.tid >> 6; l.lane = l.tid & 63; l.wr = l.wid >> 2; l.wc = l.wid & 3; l.fr = l.lane & 15; l.fq = l.lane >> 4; return l; }

template <bool PERM>
__device__ __forceinline__ void gemm_tile(const Lane& L, LAS unsigned char* lds, const bf16_t* __restrict__ A, int lda, const bf16_t* __restrict__ B, int ldb, int nt, f32x4 (&acc)[2][2][4][2]) {
    const int tid = L.tid, wr = L.wr, wc = L.wc, fr = L.fr, fq = L.fq;
    unsigned voffA[2], voffB[2];
#pragma unroll
    for (int i = 0; i < 2; ++i) { int R, C; stage_rc(tid * 16 + i * 8192, R, C); const int Rb = PERM ? ((R & ~31) + perm32(R & 31)) : R; voffA[i] = (unsigned)(R * lda + C) * 2u; voffB[i] = (unsigned)(Rb * ldb + C) * 2u; }
    const unsigned ldsw = (unsigned)__builtin_amdgcn_readfirstlane(tid >> 6) * 1024u;
    const int aoff = lds_byte(wr * 64 + fr, fq * 8), boff = lds_byte(wc * 32 + fr, fq * 8);
    const char* Ab = (const char*)A; const char* Bb = (const char*)B; const size_t hA = (size_t)128 * lda * 2, hB = (size_t)128 * ldb * 2;
#define GT_STAGE(sb, t) do { _Pragma("unroll") for (int _h = 0; _h < 2; ++_h) { _Pragma("unroll") for (int _i = 0; _i < 2; ++_i) { \
        __builtin_amdgcn_global_load_lds((const unsigned*)(Ab + _h * hA + (size_t)(t) * 128 + voffA[_i]), (LAS unsigned*)(lds + (sb) * 65536 + _h * HTB + ldsw + _i * 8192), 16, 0, 0); \
        __builtin_amdgcn_global_load_lds((const unsigned*)(Bb + _h * hB + (size_t)(t) * 128 + voffB[_i]), (LAS unsigned*)(lds + (sb) * 65536 + (2 + _h) * HTB + ldsw + _i * 8192), 16, 0, 0); } } } while (0)
#pragma unroll
    for (int a = 0; a < 2; ++a)
#pragma unroll
        for (int b = 0; b < 2; ++b)
#pragma unroll
            for (int m = 0; m < 4; ++m)
#pragma unroll
                for (int n = 0; n < 2; ++n) acc[a][b][m][n] = (f32x4){0.f, 0.f, 0.f, 0.f};
    { int t0 = 0; asm volatile("" : "+s"(t0)); GT_STAGE(0, t0); }
    asm volatile("s_waitcnt vmcnt(0)" ::: "memory"); __syncthreads();
    for (int t = 0; t < nt; ++t) {
        const int sb = t & 1;
        if (t + 1 < nt) { int tn = t + 1; asm volatile("" : "+s"(tn)); GT_STAGE(sb ^ 1, tn); }
        LAS unsigned char* buf = lds + sb * 65536;
#pragma unroll
        for (int ai = 0; ai < 2; ++ai) {
            __builtin_amdgcn_sched_barrier(0);
            bf16x8 At[4][2];
#pragma unroll
            for (int m = 0; m < 4; ++m)
#pragma unroll
                for (int k = 0; k < 2; ++k) At[m][k] = *(const LAS bf16x8*)(buf + ai * HTB + aoff + m * 2048 + k * 1024);
#pragma unroll
            for (int bj = 0; bj < 2; ++bj) {
                __builtin_amdgcn_sched_barrier(0);
                bf16x8 Bf[2][2];
#pragma unroll
                for (int n = 0; n < 2; ++n)
#pragma unroll
                    for (int k = 0; k < 2; ++k) Bf[n][k] = *(const LAS bf16x8*)(buf + (2 + bj) * HTB + boff + n * 2048 + k * 1024);
#pragma unroll
                for (int m = 0; m < 4; ++m)
#pragma unroll
                    for (int n = 0; n < 2; ++n)
#pragma unroll
                        for (int k = 0; k < 2; ++k) acc[ai][bj][m][n] = __builtin_amdgcn_mfma_f32_16x16x32_bf16(Bf[n][k], At[m][k], acc[ai][bj][m][n], 0, 0, 0);
            }
        }
        asm volatile("s_waitcnt vmcnt(0)" ::: "memory"); __syncthreads();
    }
#undef GT_STAGE
}

struct GU { const char* A; const char* B; int pm, pn; };
template <bool PERM, class Next, class Epi>
__device__ __forceinline__ void gemm_stream(const Lane& L, LAS unsigned char* lds, const int K, const Next& next, const Epi& epi) {
    int tid = L.tid; asm volatile("" : "+v"(tid));
    const int wid = __builtin_amdgcn_readfirstlane(tid >> 6), wr = wid >> 2, wc = wid & 3, fr = tid & 15, fq = (tid >> 4) & 3;
    const int nt = K / 64;
    unsigned voffA[2], voffB[2];
#pragma unroll
    for (int i = 0; i < 2; ++i) { int R, C; stage_rc(tid * 16 + i * 8192, R, C); const int Rb = PERM ? ((R & ~31) + perm32(R & 31)) : R; voffA[i] = (unsigned)(R * K + C) * 2u; voffB[i] = (unsigned)(Rb * K + C) * 2u; }
    const size_t kstep = 128, hstep = (size_t)128 * K * 2;
    const unsigned ldsw = (unsigned)wid * 1024u;
    const int aoff = lds_byte(wr * 64 + fr, fq * 8), boff = lds_byte(wc * 32 + fr, fq * 8);
#define GS_SA(b, h) (((b) * 2 + (h)) * HTB)
#define GS_SB(b, h) ((4 + (b) * 2 + (h)) * HTB)
#define GS_STAGE(bufoff, gbase, voff) do { _Pragma("unroll") for (int _i = 0; _i < 2; ++_i) \
        __builtin_amdgcn_global_load_lds((const unsigned*)((const char*)(gbase) + (voff)[_i]), (LAS unsigned*)(lds + (bufoff) + ldsw + _i * 8192), 16, 0, 0); } while (0)
#define GS_LDA(dst, b, h) do { _Pragma("unroll") for (int m = 0; m < 4; ++m) _Pragma("unroll") for (int k = 0; k < 2; ++k) dst[m][k] = *(const LAS bf16x8*)(lds + GS_SA(b, h) + aoff + m * 2048 + k * 1024); } while (0)
#define GS_LDB(dst, b, h) do { _Pragma("unroll") for (int n = 0; n < 2; ++n) _Pragma("unroll") for (int k = 0; k < 2; ++k) dst[n][k] = *(const LAS bf16x8*)(lds + GS_SB(b, h) + boff + n * 2048 + k * 1024); } while (0)
#define GS_MMA(ai, bj, At_, Bt_) do { __builtin_amdgcn_s_setprio(1); _Pragma("unroll") for (int m = 0; m < 4; ++m) _Pragma("unroll") for (int n = 0; n < 2; ++n) _Pragma("unroll") for (int k = 0; k < 2; ++k) \
        acc[ai][bj][m][n] = __builtin_amdgcn_mfma_f32_16x16x32_bf16(Bt_[n][k], At_[m][k], acc[ai][bj][m][n], 0, 0, 0); __builtin_amdgcn_s_setprio(0); } while (0)
#define GS_WAIT_V(n) asm volatile("s_waitcnt vmcnt(" #n ")" ::: "memory")
#define GS_WAIT_L(n) asm volatile("s_waitcnt lgkmcnt(" #n ")" ::: "memory")
#define GS_BAR __builtin_amdgcn_s_barrier()
#define GS_SCHED __builtin_amdgcn_sched_barrier(0)
#define GS_ZERO() do { _Pragma("unroll") for (int a = 0; a < 2; ++a) _Pragma("unroll") for (int b = 0; b < 2; ++b) _Pragma("unroll") for (int m = 0; m < 4; ++m) _Pragma("unroll") for (int n = 0; n < 2; ++n) acc[a][b][m][n] = (f32x4){0.f, 0.f, 0.f, 0.f}; } while (0)
    GU cur, nxt; int ui = 0;
    if (!next(0, cur)) return;
    f32x4 acc[2][2][4][2];
    GS_ZERO();
    bf16x8 At[4][2], B0[2][2], B1[2][2];
    const char* cA = cur.A; const char* cB = cur.B;
    GS_STAGE(GS_SB(0, 0), cB, voffB); GS_STAGE(GS_SA(0, 0), cA, voffA); GS_STAGE(GS_SB(0, 1), cB + hstep, voffB); GS_STAGE(GS_SA(0, 1), cA + hstep, voffA);
    if (wr == 1) GS_BAR;
    GS_WAIT_V(4); GS_BAR;
    GS_STAGE(GS_SB(1, 0), cB + kstep, voffB); GS_STAGE(GS_SA(1, 0), cA + kstep, voffA); GS_STAGE(GS_SB(1, 1), cB + hstep + kstep, voffB);
    GS_WAIT_V(6); GS_BAR;
    for (;;) {
        const bool has_next = next(ui + 1, nxt);
        const char* nA = has_next ? nxt.A : cA; const char* nB = has_next ? nxt.B : cB;
        for (int t = 0; t < nt; t += 2) {
            const bool last = (t == nt - 2);
            const char* a1 = cA + (size_t)(t + 1) * kstep;
            const char* a2 = last ? nA : cA + (size_t)(t + 2) * kstep; const char* b2 = last ? nB : cB + (size_t)(t + 2) * kstep;
            const char* a3 = a2 + kstep; const char* b3 = b2 + kstep;
            GS_LDB(B0, 0, 0); GS_SCHED; GS_LDA(At, 0, 0); GS_STAGE(GS_SA(1, 1), a1 + hstep, voffA);
            GS_WAIT_L(8); GS_BAR; GS_WAIT_L(0); GS_MMA(0, 0, At, B0); GS_BAR; GS_SCHED;
            GS_LDB(B1, 0, 1); GS_STAGE(GS_SB(0, 0), b2, voffB);
            GS_BAR; GS_WAIT_L(0); GS_MMA(0, 1, At, B1); GS_BAR;
            GS_LDA(At, 0, 1); GS_STAGE(GS_SA(0, 0), a2, voffA);
            GS_BAR; GS_WAIT_L(0); GS_MMA(1, 0, At, B0); GS_BAR; GS_SCHED;
            GS_STAGE(GS_SB(0, 1), b2 + hstep, voffB);
            GS_WAIT_V(6); GS_BAR; GS_MMA(1, 1, At, B1); GS_BAR;
            GS_LDB(B0, 1, 0); GS_SCHED; GS_LDA(At, 1, 0); GS_STAGE(GS_SA(0, 1), a2 + hstep, voffA);
            GS_WAIT_L(8); GS_BAR; GS_WAIT_L(0); GS_MMA(0, 0, At, B0); GS_BAR; GS_SCHED;
            GS_LDB(B1, 1, 1); GS_STAGE(GS_SB(1, 0), b3, voffB);
            GS_BAR; GS_WAIT_L(0); GS_MMA(0, 1, At, B1); GS_BAR;
            GS_LDA(At, 1, 1); GS_STAGE(GS_SA(1, 0), a3, voffA);
            GS_BAR; GS_WAIT_L(0); GS_MMA(1, 0, At, B0); GS_BAR; GS_SCHED;
            GS_STAGE(GS_SB(1, 1), b3 + hstep, voffB);
            GS_WAIT_V(6); GS_BAR; GS_MMA(1, 1, At, B1); GS_BAR;
        }
        epi(acc, cur);
        if (!has_next) break;
        GS_ZERO();
        cur = nxt; cA = nA; cB = nB; ++ui;
    }
    GS_WAIT_V(0);
    if (wr == 0) GS_BAR;
    GS_BAR;
#undef GS_SA
#undef GS_SB
#undef GS_STAGE
#undef GS_LDA
#undef GS_LDB
#undef GS_MMA
#undef GS_WAIT_V
#undef GS_WAIT_L
#undef GS_BAR
#undef GS_SCHED
#undef GS_ZERO
}

__device__ __forceinline__ void transpose_job(const Lane& L, LAS float* tile, const float* __restrict__ src, int ld, int K, int N, bf16_t* __restrict__ dst, int dstld, int mapkind, int rowoff) {
    const int tn = N / 64, ntile = (K / 64) * tn;
    for (int tl = L.bid; tl < ntile; tl += gridDim.x) {
        const int k0 = (tl / tn) * 64, n0 = (tl % tn) * 64;
        __syncthreads();
        for (int e = L.tid; e < 4096; e += NTHREADS) { const int r = e >> 6, c = e & 63; tile[r * 65 + c] = src[(size_t)(k0 + r) * ld + n0 + c]; }
        __syncthreads();
        for (int e = L.tid; e < 4096; e += NTHREADS) { const int r = e >> 6, c = e & 63; const int n = n0 + r;
            const int drow = mapkind == 0 ? rowoff + n : ((n >> 7) * 256 + rowoff + (n & 127));
            dst[(size_t)drow * dstld + k0 + c] = f2bf(tile[c * 65 + r]); }
    }
}

__device__ __forceinline__ void phase_prep(const Params& p, LAS unsigned char* lds) {
    LAS float* tile = (LAS float*)lds;
    LAS float* ctab = (LAS float*)(lds + 32768);
    const Lane L = get_lane(); const int tid = L.tid;
    if (tid < 64) ctab[tid] = cospif((float)tid * (1.0f / 32.0f));
    __syncthreads();
    const size_t gtid = (size_t)L.bid * NTHREADS + tid, gsz = (size_t)gridDim.x * NTHREADS;
    for (int l = 0; l < 2; ++l) {
        unsigned char* wl = p.ws + WS_W + (size_t)l * W_LAYER;
        for (int f = 0; f < 2; ++f) {
            transpose_job(L, tile, p.in[4] + (size_t)(l * 2 + f) * D * DFF, DFF, D, DFF, (bf16_t*)(wl + W_UP) + (size_t)f * 5632 * 1024, 1024, 1, 0);
            transpose_job(L, tile, p.in[5] + (size_t)(l * 2 + f) * D * DFF, DFF, D, DFF, (bf16_t*)(wl + W_UP) + (size_t)f * 5632 * 1024, 1024, 1, 128);
            transpose_job(L, tile, p.in[6] + (size_t)(l * 2 + f) * DFF * D, D, DFF, D, (bf16_t*)(wl + W_DN) + (size_t)f * 1024 * DFF, DFF, 0, 0);
        }
        const float* win = p.in[7] + (size_t)l * D * 1792;
        transpose_job(L, tile, win, 1792, D, 768, (bf16_t*)(wl + W_IN), 1024, 0, 0);
        transpose_job(L, tile, win + 1024, 1792, D, 512, (bf16_t*)(wl + W_IN), 1024, 0, 768);
        for (int i = 0; i < 4; ++i) {
            transpose_job(L, tile, p.in[15] + (size_t)(l * 4 + i) * D * D, D, D, D, (bf16_t*)(wl + W_G), 1024, 0, i * 1024);
            transpose_job(L, tile, p.in[17] + (size_t)(l * 4 + i) * 256 * D, D, 256, D, (bf16_t*)(wl + W_B) + (size_t)i * 1024 * 256, 256, 0, 0);
        }
        transpose_job(L, tile, p.in[18] + (size_t)l * D * D, D, D, D, (bf16_t*)(wl + W_O), 1024, 0, 0);
        { const float* pw = p.in[13] + (size_t)l * 4 * 64 * 64; const float* psc = p.in[14] + (size_t)l * 256; bf16_t* dst = (bf16_t*)(wl + W_IN);
          for (size_t idx = gtid; idx < 256 * 1024; idx += gsz) { const int n = (int)(idx >> 10), d = (int)(idx & 1023), g = n >> 6, e = n & 63; float s = 0.f;
              const float* wr_ = win + (size_t)d * 1792 + 1536 + g * 64; const float* pg = pw + (size_t)g * 4096 + e;
              for (int c = 0; c < 64; ++c) s += wr_[c] * pg[c * 64];
              dst[(size_t)(1280 + n) * 1024 + d] = f2bf(s * psc[n]); } }
        { bf16_t* dst = (bf16_t*)(wl + W_F);
          for (size_t idx = gtid; idx < 512 * 1024; idx += gsz) { const int n = (int)(idx >> 10), d = (int)(idx & 1023), part = n >> 8, hh = (n >> 6) & 3, mm = n & 63; float s = 0.f;
              const float* wr_ = win + (size_t)d * 1792 + 768 + hh * 64; const int sh = part ? 16 : 0;
              for (int c = 0; c < 64; ++c) s += wr_[c] * ctab[((mm * c) - sh) & 63];
              dst[(size_t)n * 1024 + d] = f2bf(s); } }
    }
    { bf16_t* d4 = (bf16_t*)(p.ws + WS_DFT4);
      for (size_t idx = gtid; idx < (size_t)4096 * 1024; idx += gsz) { const int k = (int)(idx >> 10), c8 = (int)(idx & 1023) * 8; float v[8];
#pragma unroll
          for (int e = 0; e < 8; ++e) { const int col = c8 + e, s = col & 4095, j = (k * s) & 4095; const float x = (float)j * (1.0f / 2048.0f); v[e] = (col >> 12) ? -sinpif(x) : cospif(x); }
          u32x4 w; w.x = cvt_pk_bf16(v[0], v[1]); w.y = cvt_pk_bf16(v[2], v[3]); w.z = cvt_pk_bf16(v[4], v[5]); w.w = cvt_pk_bf16(v[6], v[7]);
          *(u32x4*)(d4 + (size_t)k * 8192 + c8) = w; }
      bf16_t* d2 = (bf16_t*)(p.ws + WS_DFT2);
      for (size_t idx = gtid; idx < (size_t)2048 * 512; idx += gsz) { const int k = (int)(idx >> 9), c8 = (int)(idx & 511) * 8; float v[8];
#pragma unroll
          for (int e = 0; e < 8; ++e) { const int col = c8 + e, s = col & 2047, j = (k * s) & 2047; const float x = (float)j * (1.0f / 1024.0f); v[e] = (col >> 11) ? -sinpif(x) : cospif(x); }
          u32x4 w; w.x = cvt_pk_bf16(v[0], v[1]); w.y = cvt_pk_bf16(v[2], v[3]); w.z = cvt_pk_bf16(v[4], v[5]); w.w = cvt_pk_bf16(v[6], v[7]);
          *(u32x4*)(d2 + (size_t)k * 4096 + c8) = w; } }
    { const f32x4* xp = (const f32x4*)p.in[0]; const f32x4* xs = (const f32x4*)p.in[1]; f32x4* xo = (f32x4*)p.out; u32x2* xb = (u32x2*)(p.ws + WS_XB);
      for (size_t idx = gtid; idx < (size_t)T * 256; idx += gsz) { const f32x4 v = idx < (size_t)TP * 256 ? xp[idx] : xs[idx - (size_t)TP * 256]; xo[idx] = v;
          u32x2 w; w.x = cvt_pk_bf16(v[0], v[1]); w.y = cvt_pk_bf16(v[2], v[3]); xb[idx] = w; } }
}

__device__ __forceinline__ void phase_ln(const Params& p, int l, int which) {
    const Lane L = get_lane();
    const float* g = p.in[2] + (size_t)(l * 3 + which) * 1024; const float* b = p.in[3] + (size_t)(l * 3 + which) * 1024;
    f32x4 gv[4], bv[4];
#pragma unroll
    for (int j = 0; j < 4; ++j) { gv[j] = *(const f32x4*)(g + j * 256 + L.lane * 4); bv[j] = *(const f32x4*)(b + j * 256 + L.lane * 4); }
    bf16_t* xb = (bf16_t*)(p.ws + WS_XB);
    for (int row = L.bid * 8 + L.wid; row < T; row += gridDim.x * 8) {
        float* rp = p.out + (size_t)row * 1024 + L.lane * 4; f32x4 v[4]; float s = 0.f;
#pragma unroll
        for (int j = 0; j < 4; ++j) { v[j] = *(const f32x4*)(rp + j * 256); s += (v[j][0] + v[j][1]) + (v[j][2] + v[j][3]); }
        const float mean = wave_sum(s, L.lane) * (1.0f / 1024.0f); float q = 0.f;
#pragma unroll
        for (int j = 0; j < 4; ++j) { const f32x4 d = v[j] - mean; q += (d[0] * d[0] + d[1] * d[1]) + (d[2] * d[2] + d[3] * d[3]); }
        const float rstd = rsqrtf(wave_sum(q, L.lane) * (1.0f / 1024.0f) + LN_EPS);
#pragma unroll
        for (int j = 0; j < 4; ++j) { const f32x4 o = (v[j] - mean) * rstd * gv[j] + bv[j]; *(f32x4*)(rp + j * 256) = o;
            u32x2 w; w.x = cvt_pk_bf16(o[0], o[1]); w.y = cvt_pk_bf16(o[2], o[3]); *(u32x2*)(xb + (size_t)row * 1024 + j * 256 + L.lane * 4) = w; }
    }
}

__device__ __forceinline__ u32x4 pack8(const f32x4& a, const f32x4& b) { u32x4 w; w.x = cvt_pk_bf16(a[0], a[1]); w.y = cvt_pk_bf16(a[2], a[3]); w.z = cvt_pk_bf16(b[0], b[1]); w.w = cvt_pk_bf16(b[2], b[3]); return w; }

__device__ __forceinline__ void phase_ffn_up(const Params& p, LAS unsigned char* lds, int l, int f) {
    const Lane L = get_lane();
    const bf16_t* xb = (const bf16_t*)(p.ws + WS_XB); const bf16_t* W = (const bf16_t*)(p.ws + WS_W + (size_t)l * W_LAYER + W_UP) + (size_t)f * 5632 * 1024; bf16_t* H = (bf16_t*)(p.ws + WS_H);
    const int G = gridDim.x, bid = L.bid;
    auto next = [=](int i, GU& u) -> bool { int pm, pn; if (!tile_order(i * G + bid, 320, 22, pm, pn)) return false;
        u.A = (const char*)(xb + (size_t)pm * 256 * 1024); u.B = (const char*)(W + (size_t)pn * 256 * 1024); u.pm = pm; u.pn = pn; return true; };
    auto epi = [=](f32x4 (&acc)[2][2][4][2], const GU& u) {
        const int row0 = u.pm * 256 + L.wr * 64 + L.fr, col0 = u.pn * 128 + L.wc * 32 + 8 * L.fq;
#pragma unroll
        for (int ai = 0; ai < 2; ++ai)
#pragma unroll
            for (int m = 0; m < 4; ++m) { f32x4 o[2];
#pragma unroll
                for (int n = 0; n < 2; ++n)
#pragma unroll
                    for (int j = 0; j < 4; ++j) o[n][j] = silu_f(acc[ai][0][m][n][j]) * acc[ai][1][m][n][j];
                *(u32x4*)(H + (size_t)(row0 + ai * 128 + m * 16) * DFF + col0) = pack8(o[0], o[1]); }
    };
    gemm_stream<true>(L, lds, 1024, next, epi);
}

__device__ __forceinline__ void phase_down(const Params& p, LAS unsigned char* lds, const bf16_t* A, int K, const bf16_t* W, float cscale) {
    const Lane L = get_lane();
    const int G = gridDim.x, bid = L.bid; float* out = p.out;
    auto next = [=](int i, GU& u) -> bool { int pm, pn; if (!tile_order(i * G + bid, 320, 4, pm, pn)) return false;
        u.A = (const char*)(A + (size_t)pm * 256 * K); u.B = (const char*)(W + (size_t)pn * 256 * K); u.pm = pm; u.pn = pn; return true; };
    auto epi = [=](f32x4 (&acc)[2][2][4][2], const GU& u) {
        const int row0 = u.pm * 256 + L.wr * 64 + L.fr, col0 = u.pn * 256 + L.wc * 32 + 4 * L.fq;
#pragma unroll
        for (int ai = 0; ai < 2; ++ai)
#pragma unroll
            for (int m = 0; m < 4; ++m) { float* rp = out + (size_t)(row0 + ai * 128 + m * 16) * 1024 + col0;
#pragma unroll
                for (int bj = 0; bj < 2; ++bj)
#pragma unroll
                    for (int n = 0; n < 2; ++n) { const f32x4 x = *(const f32x4*)(rp + bj * 128 + n * 16); *(f32x4*)(rp + bj * 128 + n * 16) = x * ALPHA + acc[ai][bj][m][n] * cscale; }
                asm volatile("" ::: "memory"); }
    };
    gemm_stream<false>(L, lds, K, next, epi);
}

__device__ __forceinline__ void phase_mix_in(const Params& p, LAS unsigned char* lds, int l) {
    const Lane L = get_lane();
    const bf16_t* xb = (const bf16_t*)(p.ws + WS_XB); const unsigned char* wl = p.ws + WS_W + (size_t)l * W_LAYER;
    const bf16_t* Win = (const bf16_t*)(wl + W_IN); const bf16_t* Wf = (const bf16_t*)(wl + W_F);
    bf16_t* Z = (bf16_t*)(p.ws + WS_Z); bf16_t* ZT = (bf16_t*)(p.ws + WS_ZT);
    const int G = gridDim.x, bid = L.bid;
    {
        auto next = [=](int i, GU& u) -> bool { int pm, pn; if (!tile_order(i * G + bid, 320, 6, pm, pn)) return false;
            u.A = (const char*)(xb + (size_t)pm * 256 * 1024); u.B = (const char*)(Win + (size_t)pn * 256 * 1024); u.pm = pm; u.pn = pn; return true; };
        auto epi = [=](f32x4 (&acc)[2][2][4][2], const GU& u) {
            const int row0 = u.pm * 256 + L.wr * 64 + L.fr, col0 = u.pn * 256 + L.wc * 32 + 8 * L.fq; const bool act = (u.pn == 3 || u.pn == 4);
#pragma unroll
            for (int ai = 0; ai < 2; ++ai)
#pragma unroll
                for (int m = 0; m < 4; ++m)
#pragma unroll
                    for (int bj = 0; bj < 2; ++bj) { f32x4 o0 = acc[ai][bj][m][0], o1 = acc[ai][bj][m][1];
                        if (act) {
#pragma unroll
                            for (int j = 0; j < 4; ++j) { o0[j] = gelu_tanh(o0[j]); o1[j] = gelu_tanh(o1[j]); } }
                        *(u32x4*)(Z + (size_t)(row0 + ai * 128 + m * 16) * 1536 + col0 + bj * 128) = pack8(o0, o1); }
        };
        gemm_stream<true>(L, lds, 1024, next, epi);
    }
    {
        auto next = [=](int i, GU& u) -> bool { int pm, pn; if (!tile_order(i * G + bid, 320, 2, pm, pn)) return false;
            u.A = (const char*)(Wf + (size_t)pn * 256 * 1024); u.B = (const char*)(xb + (size_t)pm * 256 * 1024); u.pm = pm; u.pn = pn; return true; };
        auto epi = [=](f32x4 (&acc)[2][2][4][2], const GU& u) {
            const int tok0 = u.pm * 256, part = u.pn;
            size_t base; int S;
            if (tok0 < TP) { S = 4096; base = (size_t)(tok0 >> 12) * 256 * 2 * 4096 + (tok0 & 4095); }
            else { S = 2048; const int t2 = tok0 - TP; base = (size_t)TP * 512 + (size_t)(t2 >> 11) * 256 * 2 * 2048 + (t2 & 2047); }
#pragma unroll
            for (int ai = 0; ai < 2; ++ai)
#pragma unroll
                for (int m = 0; m < 4; ++m) { const int colc = ai * 128 + L.wr * 64 + m * 16 + L.fr;
#pragma unroll
                    for (int bj = 0; bj < 2; ++bj)
                        *(u32x4*)(ZT + base + (size_t)(colc * 2 + part) * S + bj * 128 + L.wc * 32 + 8 * L.fq) = pack8(acc[ai][bj][m][0], acc[ai][bj][m][1]); }
        };
        gemm_stream<true>(L, lds, 1024, next, epi);
    }
}

__device__ __forceinline__ void phase_dft(const Params& p, LAS unsigned char* lds) {
    const Lane L = get_lane();
    const bf16_t* ZT = (const bf16_t*)(p.ws + WS_ZT); bf16_t* BR1 = (bf16_t*)(p.ws + WS_BR) + (size_t)1 * T * 256;
    const bf16_t* D4 = (const bf16_t*)(p.ws + WS_DFT4); const bf16_t* D2 = (const bf16_t*)(p.ws + WS_DFT2);
    const int G = gridDim.x, bid = L.bid;
    {
        auto next = [=](int i, GU& u) -> bool { const int v = i * G + bid; if (v >= 256) return false; const int b = v >> 4, pm = v & 15;
            u.A = (const char*)(D4 + (size_t)pm * 256 * 8192); u.B = (const char*)(ZT + (size_t)b * 256 * 8192); u.pm = b * 4096 + pm * 256; u.pn = 0; return true; };
        auto epi = [=](f32x4 (&acc)[2][2][4][2], const GU& u) {
            const int row0 = u.pm + L.wr * 64 + L.fr, col0 = L.wc * 32 + 8 * L.fq; const float scale = 1.0f / 512.0f;
#pragma unroll
            for (int ai = 0; ai < 2; ++ai)
#pragma unroll
                for (int m = 0; m < 4; ++m)
#pragma unroll
                    for (int bj = 0; bj < 2; ++bj)
                        *(u32x4*)(BR1 + (size_t)(row0 + ai * 128 + m * 16) * 256 + col0 + bj * 128) = pack8(acc[ai][bj][m][0] * scale, acc[ai][bj][m][1] * scale);
        };
        gemm_stream<true>(L, lds, 8192, next, epi);
    }
    {
        auto next = [=](int i, GU& u) -> bool { const int v = i * G + (G - 1 - bid); if (v >= 64) return false; const int b = v >> 3, pm = v & 7;
            u.A = (const char*)(D2 + (size_t)pm * 256 * 4096); u.B = (const char*)(ZT + (size_t)TP * 512 + (size_t)b * 256 * 4096); u.pm = TP + b * 2048 + pm * 256; u.pn = 0; return true; };
        auto epi = [=](f32x4 (&acc)[2][2][4][2], const GU& u) {
            const int row0 = u.pm + L.wr * 64 + L.fr, col0 = L.wc * 32 + 8 * L.fq; const float scale = 0.00276213586400995f;
#pragma unroll
            for (int ai = 0; ai < 2; ++ai)
#pragma unroll
                for (int m = 0; m < 4; ++m)
#pragma unroll
                    for (int bj = 0; bj < 2; ++bj)
                        *(u32x4*)(BR1 + (size_t)(row0 + ai * 128 + m * 16) * 256 + col0 + bj * 128) = pack8(acc[ai][bj][m][0] * scale, acc[ai][bj][m][1] * scale);
        };
        gemm_stream<true>(L, lds, 4096, next, epi);
    }
}

__device__ __forceinline__ void phase_mixers(const Params& p, LAS unsigned char* lds, int l) {
    const Lane L = get_lane(); const int tid = L.tid;
    const bf16_t* Z = (const bf16_t*)(p.ws + WS_Z);
    bf16_t* BR0 = (bf16_t*)(p.ws + WS_BR); bf16_t* BR2 = BR0 + (size_t)2 * T * 256; bf16_t* BR3 = BR0 + (size_t)3 * T * 256;
    const size_t gtid = (size_t)L.bid * NTHREADS + tid, gsz = (size_t)gridDim.x * NTHREADS;
    const float* cw = p.in[8] + (size_t)l * 3 * 256;
    for (size_t idx = gtid; idx < (size_t)T * 32; idx += gsz) {
        const int t = (int)(idx >> 5), c8 = (int)(idx & 31) * 8; int s, S; if (t < TP) { s = t & 4095; S = 4096; } else { s = (t - TP) & 2047; S = 2048; }
        const bf16_t* zr = Z + (size_t)t * 1536 + c8;
        { const u32x4 hv = *(const u32x4*)zr, gb = *(const u32x4*)(zr + 256), gc = *(const u32x4*)(zr + 512);
          u32x4 hp = (u32x4){0u, 0u, 0u, 0u}, cp = hp, hn = hp, cn = hp;
          if (s > 0) { hp = *(const u32x4*)(zr - 1536); cp = *(const u32x4*)(zr - 1536 + 512); }
          if (s + 1 < S) { hn = *(const u32x4*)(zr + 1536); cn = *(const u32x4*)(zr + 1536 + 512); }
          const f32x4 w0a = *(const f32x4*)(cw + c8), w0b = *(const f32x4*)(cw + c8 + 4), w1a = *(const f32x4*)(cw + 256 + c8), w1b = *(const f32x4*)(cw + 256 + c8 + 4), w2a = *(const f32x4*)(cw + 512 + c8), w2b = *(const f32x4*)(cw + 512 + c8 + 4);
          float o[8];
#pragma unroll
          for (int e = 0; e < 4; ++e) {
              const float k0l = e < 2 ? w0a[2 * e] : w0b[2 * e - 4], k0h = e < 2 ? w0a[2 * e + 1] : w0b[2 * e - 3];
              const float k1l = e < 2 ? w1a[2 * e] : w1b[2 * e - 4], k1h = e < 2 ? w1a[2 * e + 1] : w1b[2 * e - 3];
              const float k2l = e < 2 ? w2a[2 * e] : w2b[2 * e - 4], k2h = e < 2 ? w2a[2 * e + 1] : w2b[2 * e - 3];
              o[2 * e] = bflo(gb[e]) * (k0l * bflo(cp[e]) * bflo(hp[e]) + k1l * bflo(gc[e]) * bflo(hv[e]) + k2l * bflo(cn[e]) * bflo(hn[e]));
              o[2 * e + 1] = bfhi(gb[e]) * (k0h * bfhi(cp[e]) * bfhi(hp[e]) + k1h * bfhi(gc[e]) * bfhi(hv[e]) + k2h * bfhi(cn[e]) * bfhi(hn[e])); }
          u32x4 w; w.x = cvt_pk_bf16(o[0], o[1]); w.y = cvt_pk_bf16(o[2], o[3]); w.z = cvt_pk_bf16(o[4], o[5]); w.w = cvt_pk_bf16(o[6], o[7]);
          *(u32x4*)(BR0 + (size_t)t * 256 + c8) = w; }
        { const int half = 1 << (c8 >> 6); const int lo = s - half < 0 ? 0 : s - half, hi = s + half > S ? S : s + half;
          float sum[8];
#pragma unroll
          for (int e = 0; e < 8; ++e) sum[e] = 0.f;
          for (int j = lo; j < hi; ++j) { const u32x4 v = *(const u32x4*)(zr + 1280 + (ptrdiff_t)(j - s) * 1536);
#pragma unroll
              for (int e = 0; e < 4; ++e) { sum[2 * e] += bflo(v[e]); sum[2 * e + 1] += bfhi(v[e]); } }
          const float inv = 1.0f / (float)(hi - lo); const u32x4 zc = *(const u32x4*)(zr + 1280);
          u32x4 w;
#pragma unroll
          for (int e = 0; e < 4; ++e) w[e] = cvt_pk_bf16(sum[2 * e] * inv - bflo(zc[e]), sum[2 * e + 1] * inv - bfhi(zc[e]));
          *(u32x4*)(BR3 + (size_t)t * 256 + c8) = w; }
    }
    LAS bf16_t* VT = (LAS bf16_t*)lds;
    LAS float* red = (LAS float*)(lds + 69632);
    const float* lg = p.in[9] + (size_t)l * 256; const float* lb = p.in[10] + (size_t)l * 256;
    const float* sw = p.in[11] + (size_t)l * 4 * 128 * 128; const float* sb = p.in[12] + (size_t)l * 4 * 128;
    for (int ch = L.bid; ch < T / 128; ch += gridDim.x) {
        const int t0 = ch * 128, q = tid & 127, part = tid >> 7;
        const bf16_t* vp = Z + (size_t)(t0 + q) * 1536 + 1024 + part * 64;
        __syncthreads();
        float s = 0.f, ss = 0.f;
#pragma unroll
        for (int j = 0; j < 8; ++j) { const u32x4 w = *(const u32x4*)(vp + j * 8);
#pragma unroll
            for (int e = 0; e < 4; ++e) { const float a = bflo(w[e]), b = bfhi(w[e]); s += a + b; ss += a * a + b * b; } }
        red[(part * 128 + q) * 2] = s; red[(part * 128 + q) * 2 + 1] = ss;
        __syncthreads();
        float S1 = 0.f, S2 = 0.f;
#pragma unroll
        for (int pp = 0; pp < 4; ++pp) { S1 += red[(pp * 128 + q) * 2]; S2 += red[(pp * 128 + q) * 2 + 1]; }
        const float mean = S1 * (1.0f / 256.0f), var = S2 * (1.0f / 256.0f) - mean * mean, rstd = rsqrtf((var > 0.f ? var : 0.f) + LN_EPS);
#pragma unroll
        for (int j = 0; j < 8; ++j) { const u32x4 w = *(const u32x4*)(vp + j * 8); const int c0 = part * 64 + j * 8;
#pragma unroll
            for (int e = 0; e < 4; ++e) { const float a = (bflo(w[e]) - mean) * rstd * lg[c0 + 2 * e] + lb[c0 + 2 * e], b = (bfhi(w[e]) - mean) * rstd * lg[c0 + 2 * e + 1] + lb[c0 + 2 * e + 1];
                VT[(c0 + 2 * e) * 136 + q] = f2bf(a); VT[(c0 + 2 * e + 1) * 136 + q] = f2bf(b); } }
        __syncthreads();
        const int hh = L.wid >> 1, ph = L.wid & 1;
        f32x4 a2[4][4];
#pragma unroll
        for (int ct = 0; ct < 4; ++ct)
#pragma unroll
            for (int pt = 0; pt < 4; ++pt) a2[ct][pt] = (f32x4){0.f, 0.f, 0.f, 0.f};
#pragma unroll
        for (int ks = 0; ks < 4; ++ks) {
            bf16x8 wf[4];
#pragma unroll
            for (int pt = 0; pt < 4; ++pt) { const float* wp = sw + ((size_t)(hh * 128 + ph * 64 + pt * 16 + L.fr) * 128 + ks * 32 + L.fq * 8);
                const f32x4 w0 = *(const f32x4*)wp, w1 = *(const f32x4*)(wp + 4); wf[pt] = __builtin_bit_cast(bf16x8, pack8(w0, w1)); }
#pragma unroll
            for (int ct = 0; ct < 4; ++ct) { const bf16x8 vf = *(const LAS bf16x8*)(VT + (hh * 64 + ct * 16 + L.fr) * 136 + ks * 32 + L.fq * 8);
#pragma unroll
                for (int pt = 0; pt < 4; ++pt) a2[ct][pt] = __builtin_amdgcn_mfma_f32_16x16x32_bf16(vf, wf[pt], a2[ct][pt], 0, 0, 0); }
        }
#pragma unroll
        for (int pt = 0; pt < 4; ++pt) { const int pp = ph * 64 + pt * 16 + L.fr, t = t0 + pp; const float bias = sb[hh * 128 + pp];
#pragma unroll
            for (int ct = 0; ct < 4; ++ct) { const int c = hh * 64 + ct * 16 + 4 * L.fq; const u32x2 u = *(const u32x2*)(Z + (size_t)t * 1536 + 768 + c);
                u32x2 w; w.x = cvt_pk_bf16(bflo(u.x) * (a2[ct][pt][0] + bias), bfhi(u.x) * (a2[ct][pt][1] + bias)); w.y = cvt_pk_bf16(bflo(u.y) * (a2[ct][pt][2] + bias), bfhi(u.y) * (a2[ct][pt][3] + bias));
                *(u32x2*)(BR2 + (size_t)t * 256 + c) = w; } }
    }
}

__device__ __forceinline__ void phase_gate_branch(const Params& p, LAS unsigned char* lds, int l) {
    const Lane L = get_lane();
    const bf16_t* xb = (const bf16_t*)(p.ws + WS_XB); const unsigned char* wl = p.ws + WS_W + (size_t)l * W_LAYER;
    const bf16_t* Wg = (const bf16_t*)(wl + W_G); const bf16_t* Wb = (const bf16_t*)(wl + W_B); const bf16_t* BR = (const bf16_t*)(p.ws + WS_BR);
    const float* bg = p.in[16] + (size_t)l * 4 * 1024; bf16_t* MRG = (bf16_t*)(p.ws + WS_MRG);
    unsigned char* scr = p.ws + WS_SCR + (size_t)L.bid * 393216;
    for (int it = 0;; ++it) { int pm, pn; if (!tile_order(it * gridDim.x + L.bid, 320, 4, pm, pn)) break;
#pragma unroll 1
        for (int i = 0; i < 4; ++i) {
            {
                auto next = [=](int k, GU& u) -> bool { if (k > 0) return false; u.A = (const char*)(xb + (size_t)pm * 256 * 1024); u.B = (const char*)(Wg + (size_t)(i * 1024 + pn * 256) * 1024); u.pm = pm; u.pn = pn; return true; };
                auto epi = [=](f32x4 (&acc)[2][2][4][2], const GU& u) {
                    unsigned loff = (unsigned)L.tid * 16u; asm volatile("" : "+v"(loff));
                    const int col0 = u.pn * 256 + L.wc * 32 + 8 * L.fq;
#pragma unroll
                    for (int bj = 0; bj < 2; ++bj) { const f32x4 b0 = *(const f32x4*)(bg + i * 1024 + col0 + bj * 128), b1 = *(const f32x4*)(bg + i * 1024 + col0 + bj * 128 + 4);
#pragma unroll
                        for (int ai = 0; ai < 2; ++ai)
#pragma unroll
                            for (int m = 0; m < 4; ++m) { f32x4 g0 = acc[ai][bj][m][0] + b0, g1 = acc[ai][bj][m][1] + b1;
#pragma unroll
                                for (int j = 0; j < 4; ++j) { g0[j] = sigmoid_f(g0[j]); g1[j] = sigmoid_f(g1[j]); }
                                *(u32x4*)(scr + (loff + (unsigned)(((ai * 2 + bj) * 4 + m) * 8192))) = pack8(g0, g1); asm volatile("" ::: "memory"); __builtin_amdgcn_sched_barrier(0); } }
                };
                gemm_stream<true>(L, lds, 1024, next, epi);
            }
            {
                auto next = [=](int k, GU& u) -> bool { if (k > 0) return false; u.A = (const char*)(BR + ((size_t)i * T + (size_t)pm * 256) * 256); u.B = (const char*)(Wb + ((size_t)i * 1024 + pn * 256) * 256); u.pm = pm; u.pn = pn; return true; };
                auto epi = [=](f32x4 (&acc)[2][2][4][2], const GU& u) {
                    unsigned loff = (unsigned)L.tid * 16u; asm volatile("" : "+v"(loff));
                    int row0o = u.pm * 256 + L.wr * 64 + L.fr; asm volatile("" : "+v"(row0o));
                    const int col0 = u.pn * 256 + L.wc * 32 + 8 * L.fq;
#pragma unroll
                    for (int ai = 0; ai < 2; ++ai)
#pragma unroll
                        for (int bj = 0; bj < 2; ++bj)
#pragma unroll
                            for (int m = 0; m < 4; ++m) { const int slot = (ai * 2 + bj) * 4 + m; const u32x4 g = *(const u32x4*)(scr + (loff + (unsigned)(slot * 8192)));
                                f32x4 v0 = acc[ai][bj][m][0] * (f32x4){bflo(g.x), bfhi(g.x), bflo(g.y), bfhi(g.y)}, v1 = acc[ai][bj][m][1] * (f32x4){bflo(g.z), bfhi(g.z), bflo(g.w), bfhi(g.w)};
                                if (i > 0) { v0 += *(const f32x4*)(scr + (loff + (unsigned)(131072 + (slot * 2) * 8192))); v1 += *(const f32x4*)(scr + (loff + (unsigned)(131072 + (slot * 2 + 1) * 8192))); }
                                if (i < 3) { *(f32x4*)(scr + (loff + (unsigned)(131072 + (slot * 2) * 8192))) = v0; *(f32x4*)(scr + (loff + (unsigned)(131072 + (slot * 2 + 1) * 8192))) = v1; }
                                else *(u32x4*)(MRG + (size_t)(row0o + ai * 128 + m * 16) * 1024 + col0 + bj * 128) = pack8(v0, v1);
                                asm volatile("" ::: "memory"); __builtin_amdgcn_sched_barrier(0); }
                };
                gemm_stream<true>(L, lds, 256, next, epi);
            }
        }
    }
}

__global__ void __launch_bounds__(NTHREADS, 2) fwd_kernel(Params p) {
    extern __shared__ __attribute__((aligned(16))) unsigned char lds_raw[];
    LAS unsigned char* lds = (LAS unsigned char*)lds_raw;
    cg::grid_group grid = cg::this_grid();
    for (int ph = p.ph_lo; ph < p.ph_hi; ++ph) {
        if (ph > p.ph_lo) grid.sync();
        if (ph == 0) { phase_prep(p, lds); continue; }
        const int l = (ph - 1) / 11, s = (ph - 1) % 11;
        const unsigned char* wl = p.ws + WS_W + (size_t)l * W_LAYER;
        if (s == 0 || s == 8) phase_ffn_up(p, lds, l, s == 0 ? 0 : 1);
        else if (s == 1 || s == 9) phase_down(p, lds, (const bf16_t*)(p.ws + WS_H), DFF, (const bf16_t*)(wl + W_DN) + (size_t)(s == 1 ? 0 : 1) * 1024 * DFF, 0.5f);
        else if (s == 2 || s == 7 || s == 10) phase_ln(p, l, s == 2 ? 0 : (s == 7 ? 1 : 2));
        else if (s == 3) phase_mix_in(p, lds, l);
        else if (s == 4) { phase_dft(p, lds); __syncthreads(); phase_mixers(p, lds, l); }
        else if (s == 5) phase_gate_branch(p, lds, l);
        else if (s == 6) phase_down(p, lds, (const bf16_t*)(p.ws + WS_MRG), 1024, (const bf16_t*)(wl + W_O), 1.0f);
        __syncthreads();
    }
}

extern "C" void kernel_launch(void* const* d_in, const int* in_sizes, int n_in, void* d_out, int out_size, void* d_ws, size_t ws_size, hipStream_t stream) {
    static int grid = 0;
    if (grid == 0) {
        if (n_in != 19 || out_size != T * D || ws_size < WS_END) { fprintf(stderr, "kernel_launch: unexpected shapes (n_in %d, out %d, ws %zu)\n", n_in, out_size, ws_size); grid = -1; return; }
        int dev = 0, cus = 0, per_cu = 0;
        hipGetDevice(&dev); hipDeviceGetAttribute(&cus, hipDeviceAttributeMultiprocessorCount, dev);
        if (hipFuncSetAttribute((const void*)fwd_kernel, hipFuncAttributeMaxDynamicSharedMemorySize, LDS_BYTES) != hipSuccess) { fprintf(stderr, "kernel_launch: hipFuncSetAttribute failed\n"); grid = -1; return; }
        if (hipOccupancyMaxActiveBlocksPerMultiprocessor(&per_cu, (const void*)fwd_kernel, NTHREADS, LDS_BYTES) != hipSuccess || per_cu < 1) { fprintf(stderr, "kernel_launch: occupancy query says %d\n", per_cu); per_cu = 1; }
        (void)hipGetLastError();
        grid = cus * 1;
        fprintf(stderr, "kernel_launch: grid %d (cus %d, per_cu %d), ws %zu\n", grid, cus, per_cu, ws_size);
    }
    if (grid < 0) return;
    Params p{};
    for (int i = 0; i < 19; ++i) p.in[i] = (const float*)d_in[i];
    p.out = (float*)d_out; p.ws = (unsigned char*)d_ws;
#if N_LAUNCH_PER_PHASE
    for (int ph = 0; ph < NPHASE; ++ph) { p.ph_lo = ph; p.ph_hi = ph + 1; hipLaunchKernelGGL(fwd_kernel, dim3(grid), dim3(NTHREADS), LDS_BYTES, stream, p); }
#else
    p.ph_lo = 0; p.ph_hi = NPHASE;
    void* args[] = {&p};
    hipError_t e = hipLaunchCooperativeKernel((const void*)fwd_kernel, dim3(grid), dim3(NTHREADS), args, LDS_BYTES, stream);
    if (e != hipSuccess) fprintf(stderr, "cooperative launch failed: %s (grid %d)\n", hipGetErrorString(e), grid);
#endif
}
```

```cpp
#include <hip/hip_runtime.h>
#include <hip/hip_cooperative_groups.h>
#include <cstdio>
namespace cg = cooperative_groups;

#ifndef N_LAUNCH_PER_PHASE
#define N_LAUNCH_PER_PHASE 0
#endif

#define LAS __attribute__((address_space(3)))
typedef unsigned short bf16_t;
typedef short bf16x8 __attribute__((ext_vector_type(8)));
typedef float f32x4 __attribute__((ext_vector_type(4)));
typedef unsigned u32x4 __attribute__((ext_vector_type(4)));
typedef unsigned u32x2 __attribute__((ext_vector_type(2)));

constexpr int T = 81920, TP = 65536, D = 1024, DFF = 2816;
constexpr int NTHREADS = 512;
constexpr int LDS_BYTES = 147456;
constexpr int HTB = 16384;
constexpr float ALPHA = 1.41421356237309515f;
constexpr float LN_EPS = 1e-5f;

constexpr size_t MiB = 1ull << 20;
constexpr size_t WS_W = 1 * MiB;
constexpr size_t W_UP = 0;
constexpr size_t W_DN = 22 * MiB;
constexpr size_t W_IN = 33 * MiB;
constexpr size_t W_G = 36 * MiB;
constexpr size_t W_F = 44 * MiB;
constexpr size_t W_B = 45 * MiB;
constexpr size_t W_O = 47 * MiB;
constexpr size_t W_LAYER = 49 * MiB;
constexpr size_t WS_DFT4 = 99 * MiB;
constexpr size_t WS_DFT2 = 163 * MiB;
constexpr size_t WS_XB = 179 * MiB;
constexpr size_t WS_R = 339 * MiB;
constexpr size_t WS_H = WS_R;
constexpr size_t WS_Z = WS_R;
constexpr size_t WS_MRG = WS_R;
constexpr size_t WS_ZT = WS_R + 240 * MiB;
constexpr size_t WS_BR = WS_R + 320 * MiB;
constexpr size_t WS_SCR = WS_R + 480 * MiB;
constexpr size_t WS_END = 915 * MiB;
constexpr int NPHASE = 23;

struct Params { const float* in[19]; float* out; unsigned char* ws; int ph_lo, ph_hi; };

typedef __bf16 bf16x2_t __attribute__((ext_vector_type(2)));
typedef float f32x2_t __attribute__((ext_vector_type(2)));
__device__ __forceinline__ unsigned cvt_pk_bf16(float lo, float hi) { const f32x2_t v = {lo, hi}; return __builtin_bit_cast(unsigned, __builtin_convertvector(v, bf16x2_t)); }
__device__ __forceinline__ bf16_t f2bf(float f) { return (bf16_t)(cvt_pk_bf16(f, 0.f) & 0xffffu); }
__device__ __forceinline__ float bflo(unsigned w) { return __uint_as_float(w << 16); }
__device__ __forceinline__ float bfhi(unsigned w) { return __uint_as_float(w & 0xffff0000u); }
__device__ __forceinline__ float sigmoid_f(float x) { return __builtin_amdgcn_rcpf(1.0f + __expf(-x)); }
__device__ __forceinline__ float gelu_tanh(float x) { return x * sigmoid_f(1.5957691216057308f * (x + 0.044715f * x * x * x)); }
__device__ __forceinline__ float silu_f(float x) { return x * sigmoid_f(x); }
__device__ __forceinline__ float wave_sum(float v, int lane) {
#pragma unroll
    for (int o = 32; o >= 1; o >>= 1) v += __int_as_float(__builtin_amdgcn_ds_bpermute((lane ^ o) << 2, __float_as_int(v)));
    return v;
}

__device__ __forceinline__ int lds_byte(int r, int c) { const int st = (r >> 4) * 2 + (c >> 5), rr = r & 15, cc = c & 31, ob = rr * 64 + cc * 2; return st * 1024 + (ob ^ (((ob >> 9) & 1) << 5)); }
__device__ __forceinline__ void stage_rc(int b, int& R, int& C) { const int st = b / 1024, sb = b % 1024, swz = sb ^ (((sb >> 9) & 1) << 5); R = (st >> 1) * 16 + swz / 64; C = (st & 1) * 32 + (swz % 64) / 2; }
__device__ __forceinline__ int perm32(int rho) { const int n = rho >> 4, i = rho & 15; return 8 * (i >> 2) + 4 * n + (i & 3); }

__device__ __forceinline__ bool tile_order(int L, int nM, int nN, int& pm, int& pn) {
    const int nwg = nM * nN; if (L >= nwg) return false;
    int wgid = L; { const int q = nwg / 8, r = nwg % 8, xcd = wgid % 8, off = wgid / 8; wgid = (xcd < r ? xcd * (q + 1) : r * (q + 1) + (xcd - r) * q) + off; }
    const int nig = 8 * nN, gid = wgid / nig, fm = gid * 8, gsz = (nM - fm) < 8 ? (nM - fm) : 8;
    pm = fm + ((wgid % nig) % gsz); pn = (wgid % nig) / gsz; return true;
}

struct Lane { int tid, wid, lane, wr, wc, fr, fq, bid; };
__device__ __forceinline__ Lane get_lane() { Lane l; l.tid = threadIdx.x; asm volatile("" : "+v"(l.tid)); l.bid = blockIdx.x; asm volatile("" : "+s"(l.bid)); l.wid = l.tid >> 6; l.lane = l.tid & 63; l.wr = l.wid >> 2; l.wc = l.wid & 3; l.fr = l.lane & 15; l.fq = l.lane >> 4; return l; }

template <bool PERM>
__device__ __forceinline__ void gemm_tile(const Lane& L, LAS unsigned char* lds, const bf16_t* __restrict__ A, int lda, const bf16_t* __restrict__ B, int ldb, int nt, f32x4 (&acc)[2][2][4][2]) {
    const int tid = L.tid, wr = L.wr, wc = L.wc, fr = L.fr, fq = L.fq;
    unsigned voffA[2], voffB[2];
#pragma unroll
    for (int i = 0; i < 2; ++i) { int R, C; stage_rc(tid * 16 + i * 8192, R, C); const int Rb = PERM ? ((R & ~31) + perm32(R & 31)) : R; voffA[i] = (unsigned)(R * lda + C) * 2u; voffB[i] = (unsigned)(Rb * ldb + C) * 2u; }
    const unsigned ldsw = (unsigned)__builtin_amdgcn_readfirstlane(tid >> 6) * 1024u;
    const int aoff = lds_byte(wr * 64 + fr, fq * 8), boff = lds_byte(wc * 32 + fr, fq * 8);
    const char* Ab = (const char*)A; const char* Bb = (const char*)B; const size_t hA = (size_t)128 * lda * 2, hB = (size_t)128 * ldb * 2;
#define GT_STAGE(sb, t) do { _Pragma("unroll") for (int _h = 0; _h < 2; ++_h) { _Pragma("unroll") for (int _i = 0; _i < 2; ++_i) { \
        __builtin_amdgcn_global_load_lds((const unsigned*)(Ab + _h * hA + (size_t)(t) * 128 + voffA[_i]), (LAS unsigned*)(lds + (sb) * 65536 + _h * HTB + ldsw + _i * 8192), 16, 0, 0); \
        __builtin_amdgcn_global_load_lds((const unsigned*)(Bb + _h * hB + (size_t)(t) * 128 + voffB[_i]), (LAS unsigned*)(lds + (sb) * 65536 + (2 + _h) * HTB + ldsw + _i * 8192), 16, 0, 0); } } } while (0)
#pragma unroll
    for (int a = 0; a < 2; ++a)
#pragma unroll
        for (int b = 0; b < 2; ++b)
#pragma unroll
            for (int m = 0; m < 4; ++m)
#pragma unroll
                for (int n = 0; n < 2; ++n) acc[a][b][m][n] = (f32x4){0.f, 0.f, 0.f, 0.f};
    { int t0 = 0; asm volatile("" : "+s"(t0)); GT_STAGE(0, t0); }
    asm volatile("s_waitcnt vmcnt(0)" ::: "memory"); __syncthreads();
    for (int t = 0; t < nt; ++t) {
        const int sb = t & 1;
        if (t + 1 < nt) { int tn = t + 1; asm volatile("" : "+s"(tn)); GT_STAGE(sb ^ 1, tn); }
        LAS unsigned char* buf = lds + sb * 65536;
#pragma unroll
        for (int ai = 0; ai < 2; ++ai) {
            __builtin_amdgcn_sched_barrier(0);
            bf16x8 At[4][2];
#pragma unroll
            for (int m = 0; m < 4; ++m)
#pragma unroll
                for (int k = 0; k < 2; ++k) At[m][k] = *(const LAS bf16x8*)(buf + ai * HTB + aoff + m * 2048 + k * 1024);
#pragma unroll
            for (int bj = 0; bj < 2; ++bj) {
                __builtin_amdgcn_sched_barrier(0);
                bf16x8 Bf[2][2];
#pragma unroll
                for (int n = 0; n < 2; ++n)
#pragma unroll
                    for (int k = 0; k < 2; ++k) Bf[n][k] = *(const LAS bf16x8*)(buf + (2 + bj) * HTB + boff + n * 2048 + k * 1024);
#pragma unroll
                for (int m = 0; m < 4; ++m)
#pragma unroll
                    for (int n = 0; n < 2; ++n)
#pragma unroll
                        for (int k = 0; k < 2; ++k) acc[ai][bj][m][n] = __builtin_amdgcn_mfma_f32_16x16x32_bf16(Bf[n][k], At[m][k], acc[ai][bj][m][n], 0, 0, 0);
            }
        }
        asm volatile("s_waitcnt vmcnt(0)" ::: "memory"); __syncthreads();
    }
#undef GT_STAGE
}

struct GU { const char* A; const char* B; int pm, pn; };
template <bool PERM, class Next, class Epi>
__device__ __forceinline__ void gemm_stream(const Lane& L, LAS unsigned char* lds, const int K, const Next& next, const Epi& epi) {
    int tid = L.tid; asm volatile("" : "+v"(tid));
    const int wid = __builtin_amdgcn_readfirstlane(tid >> 6), wr = wid >> 2, wc = wid & 3, fr = tid & 15, fq = (tid >> 4) & 3;
    const int nt = K / 64;
    unsigned voffA[2], voffB[2];
#pragma unroll
    for (int i = 0; i < 2; ++i) { int R, C; stage_rc(tid * 16 + i * 8192, R, C); const int Rb = PERM ? ((R & ~31) + perm32(R & 31)) : R; voffA[i] = (unsigned)(R * K + C) * 2u; voffB[i] = (unsigned)(Rb * K + C) * 2u; }
    const size_t kstep = 128, hstep = (size_t)128 * K * 2;
    const unsigned ldsw = (unsigned)wid * 1024u;
    const int aoff = lds_byte(wr * 64 + fr, fq * 8), boff = lds_byte(wc * 32 + fr, fq * 8);
#define GS_SA(b, h) (((b) * 2 + (h)) * HTB)
#define GS_SB(b, h) ((4 + (b) * 2 + (h)) * HTB)
#define GS_STAGE(bufoff, gbase, voff) do { _Pragma("unroll") for (int _i = 0; _i < 2; ++_i) \
        __builtin_amdgcn_global_load_lds((const unsigned*)((const char*)(gbase) + (voff)[_i]), (LAS unsigned*)(lds + (bufoff) + ldsw + _i * 8192), 16, 0, 0); } while (0)
#define GS_LDA(dst, b, h) do { _Pragma("unroll") for (int m = 0; m < 4; ++m) _Pragma("unroll") for (int k = 0; k < 2; ++k) dst[m][k] = *(const LAS bf16x8*)(lds + GS_SA(b, h) + aoff + m * 2048 + k * 1024); } while (0)
#define GS_LDB(dst, b, h) do { _Pragma("unroll") for (int n = 0; n < 2; ++n) _Pragma("unroll") for (int k = 0; k < 2; ++k) dst[n][k] = *(const LAS bf16x8*)(lds + GS_SB(b, h) + boff + n * 2048 + k * 1024); } while (0)
#define GS_MMA(ai, bj, At_, Bt_) do { __builtin_amdgcn_s_setprio(1); _Pragma("unroll") for (int m = 0; m < 4; ++m) _Pragma("unroll") for (int n = 0; n < 2; ++n) _Pragma("unroll") for (int k = 0; k < 2; ++k) \
        acc[ai][bj][m][n] = __builtin_amdgcn_mfma_f32_16x16x32_bf16(Bt_[n][k], At_[m][k], acc[ai][bj][m][n], 0, 0, 0); __builtin_amdgcn_s_setprio(0); } while (0)
#define GS_WAIT_V(n) asm volatile("s_waitcnt vmcnt(" #n ")" ::: "memory")
#define GS_WAIT_L(n) asm volatile("s_waitcnt lgkmcnt(" #n ")" ::: "memory")
#define GS_BAR __builtin_amdgcn_s_barrier()
#define GS_SCHED __builtin_amdgcn_sched_barrier(0)
#define GS_ZERO() do { _Pragma("unroll") for (int a = 0; a < 2; ++a) _Pragma("unroll") for (int b = 0; b < 2; ++b) _Pragma("unroll") for (int m = 0; m < 4; ++m) _Pragma("unroll") for (int n = 0; n < 2; ++n) acc[a][b][m][n] = (f32x4){0.f, 0.f, 0.f, 0.f}; } while (0)
    GU cur, nxt; int ui = 0;
    if (!next(0, cur)) return;
    f32x4 acc[2][2][4][2];
    GS_ZERO();
    bf16x8 At[4][2], B0[2][2], B1[2][2];
    const char* cA = cur.A; const char* cB = cur.B;
    GS_STAGE(GS_SB(0, 0), cB, voffB); GS_STAGE(GS_SA(0, 0), cA, voffA); GS_STAGE(GS_SB(0, 1), cB + hstep, voffB); GS_STAGE(GS_SA(0, 1), cA + hstep, voffA);
    if (wr == 1) GS_BAR;
    GS_WAIT_V(4); GS_BAR;
    GS_STAGE(GS_SB(1, 0), cB + kstep, voffB); GS_STAGE(GS_SA(1, 0), cA + kstep, voffA); GS_STAGE(GS_SB(1, 1), cB + hstep + kstep, voffB);
    GS_WAIT_V(6); GS_BAR;
    for (;;) {
        const bool has_next = next(ui + 1, nxt);
        const char* nA = has_next ? nxt.A : cA; const char* nB = has_next ? nxt.B : cB;
        for (int t = 0; t < nt; t += 2) {
            const bool last = (t == nt - 2);
            const char* a1 = cA + (size_t)(t + 1) * kstep;
            const char* a2 = last ? nA : cA + (size_t)(t + 2) * kstep; const char* b2 = last ? nB : cB + (size_t)(t + 2) * kstep;
            const char* a3 = a2 + kstep; const char* b3 = b2 + kstep;
            GS_LDB(B0, 0, 0); GS_SCHED; GS_LDA(At, 0, 0); GS_STAGE(GS_SA(1, 1), a1 + hstep, voffA);
            GS_WAIT_L(8); GS_BAR; GS_WAIT_L(0); GS_MMA(0, 0, At, B0); GS_BAR; GS_SCHED;
            GS_LDB(B1, 0, 1); GS_STAGE(GS_SB(0, 0), b2, voffB);
            GS_BAR; GS_WAIT_L(0); GS_MMA(0, 1, At, B1); GS_BAR;
            GS_LDA(At, 0, 1); GS_STAGE(GS_SA(0, 0), a2, voffA);
            GS_BAR; GS_WAIT_L(0); GS_MMA(1, 0, At, B0); GS_BAR; GS_SCHED;
            GS_STAGE(GS_SB(0, 1), b2 + hstep, voffB);
            GS_WAIT_V(6); GS_BAR; GS_MMA(1, 1, At, B1); GS_BAR;
            GS_LDB(B0, 1, 0); GS_SCHED; GS_LDA(At, 1, 0); GS_STAGE(GS_SA(0, 1), a2 + hstep, voffA);
            GS_WAIT_L(8); GS_BAR; GS_WAIT_L(0); GS_MMA(0, 0, At, B0); GS_BAR; GS_SCHED;
            GS_LDB(B1, 1, 1); GS_STAGE(GS_SB(1, 0), b3, voffB);
            GS_BAR; GS_WAIT_L(0); GS_MMA(0, 1, At, B1); GS_BAR;
            GS_LDA(At, 1, 1); GS_STAGE(GS_SA(1, 0), a3, voffA);
            GS_BAR; GS_WAIT_L(0); GS_MMA(1, 0, At, B0); GS_BAR; GS_SCHED;
            GS_STAGE(GS_SB(1, 1), b3 + hstep, voffB);
            GS_WAIT_V(6); GS_BAR; GS_MMA(1, 1, At, B1); GS_BAR;
        }
        epi(acc, cur);
        if (!has_next) break;
        GS_ZERO();
        cur = nxt; cA = nA; cB = nB; ++ui;
    }
    GS_WAIT_V(0);
    if (wr == 0) GS_BAR;
    GS_BAR;
#undef GS_SA
#undef GS_SB
#undef GS_STAGE
#undef GS_LDA
#undef GS_LDB
#undef GS_MMA
#undef GS_WAIT_V
#undef GS_WAIT_L
#undef GS_BAR
#undef GS_SCHED
#undef GS_ZERO
}

__device__ __forceinline__ void transpose_job(const Lane& L, LAS float* tile, const float* __restrict__ src, int ld, int K, int N, bf16_t* __restrict__ dst, int dstld, int mapkind, int rowoff) {
    const int tn = N / 64, ntile = (K / 64) * tn;
    for (int tl = L.bid; tl < ntile; tl += gridDim.x) {
        const int k0 = (tl / tn) * 64, n0 = (tl % tn) * 64;
        __syncthreads();
        for (int e = L.tid; e < 4096; e += NTHREADS) { const int r = e >> 6, c = e & 63; tile[r * 65 + c] = src[(size_t)(k0 + r) * ld + n0 + c]; }
        __syncthreads();
        for (int e = L.tid; e < 4096; e += NTHREADS) { const int r = e >> 6, c = e & 63; const int n = n0 + r;
            const int drow = mapkind == 0 ? rowoff + n : ((n >> 7) * 256 + rowoff + (n & 127));
            dst[(size_t)drow * dstld + k0 + c] = f2bf(tile[c * 65 + r]); }
    }
}

__device__ __forceinline__ void phase_prep(const Params& p, LAS unsigned char* lds) {
    LAS float* tile = (LAS float*)lds;
    LAS float* ctab = (LAS float*)(lds + 32768);
    const Lane L = get_lane(); const int tid = L.tid;
    if (tid < 64) ctab[tid] = cospif((float)tid * (1.0f / 32.0f));
    __syncthreads();
    const size_t gtid = (size_t)L.bid * NTHREADS + tid, gsz = (size_t)gridDim.x * NTHREADS;
    for (int l = 0; l < 2; ++l) {
        unsigned char* wl = p.ws + WS_W + (size_t)l * W_LAYER;
        for (int f = 0; f < 2; ++f) {
            transpose_job(L, tile, p.in[4] + (size_t)(l * 2 + f) * D * DFF, DFF, D, DFF, (bf16_t*)(wl + W_UP) + (size_t)f * 5632 * 1024, 1024, 1, 0);
            transpose_job(L, tile, p.in[5] + (size_t)(l * 2 + f) * D * DFF, DFF, D, DFF, (bf16_t*)(wl + W_UP) + (size_t)f * 5632 * 1024, 1024, 1, 128);
            transpose_job(L, tile, p.in[6] + (size_t)(l * 2 + f) * DFF * D, D, DFF, D, (bf16_t*)(wl + W_DN) + (size_t)f * 1024 * DFF, DFF, 0, 0);
        }
        const float* win = p.in[7] + (size_t)l * D * 1792;
        transpose_job(L, tile, win, 1792, D, 768, (bf16_t*)(wl + W_IN), 1024, 0, 0);
        transpose_job(L, tile, win + 1024, 1792, D, 512, (bf16_t*)(wl + W_IN), 1024, 0, 768);
        for (int i = 0; i < 4; ++i) {
            transpose_job(L, tile, p.in[15] + (size_t)(l * 4 + i) * D * D, D, D, D, (bf16_t*)(wl + W_G), 1024, 0, i * 1024);
            transpose_job(L, tile, p.in[17] + (size_t)(l * 4 + i) * 256 * D, D, 256, D, (bf16_t*)(wl + W_B) + (size_t)i * 1024 * 256, 256, 0, 0);
        }
        transpose_job(L, tile, p.in[18] + (size_t)l * D * D, D, D, D, (bf16_t*)(wl + W_O), 1024, 0, 0);
        { const float* pw = p.in[13] + (size_t)l * 4 * 64 * 64; const float* psc = p.in[14] + (size_t)l * 256; bf16_t* dst = (bf16_t*)(wl + W_IN);
          for (size_t idx = gtid; idx < 256 * 1024; idx += gsz) { const int n = (int)(idx >> 10), d = (int)(idx & 1023), g = n >> 6, e = n & 63; float s = 0.f;
              const float* wr_ = win + (size_t)d * 1792 + 1536 + g * 64; const float* pg = pw + (size_t)g * 4096 + e;
              for (int c = 0; c < 64; ++c) s += wr_[c] * pg[c * 64];
              dst[(size_t)(1280 + n) * 1024 + d] = f2bf(s * psc[n]); } }
        { bf16_t* dst = (bf16_t*)(wl + W_F);
          for (size_t idx = gtid; idx < 512 * 1024; idx += gsz) { const int n = (int)(idx >> 10), d = (int)(idx & 1023), part = n >> 8, hh = (n >> 6) & 3, mm = n & 63; float s = 0.f;
              const float* wr_ = win + (size_t)d * 1792 + 768 + hh * 64; const int sh = part ? 16 : 0;
              for (int c = 0; c < 64; ++c) s += wr_[c] * ctab[((mm * c) - sh) & 63];
              dst[(size_t)n * 1024 + d] = f2bf(s); } }
    }
    { bf16_t* d4 = (bf16_t*)(p.ws + WS_DFT4);
      for (size_t idx = gtid; idx < (size_t)4096 * 1024; idx += gsz) { const int k = (int)(idx >> 10), c8 = (int)(idx & 1023) * 8; float v[8];
#pragma unroll
          for (int e = 0; e < 8; ++e) { const int col = c8 + e, s = col & 4095, j = (k * s) & 4095; const float x = (float)j * (1.0f / 2048.0f); v[e] = (col >> 12) ? -sinpif(x) : cospif(x); }
          u32x4 w; w.x = cvt_pk_bf16(v[0], v[1]); w.y = cvt_pk_bf16(v[2], v[3]); w.z = cvt_pk_bf16(v[4], v[5]); w.w = cvt_pk_bf16(v[6], v[7]);
          *(u32x4*)(d4 + (size_t)k * 8192 + c8) = w; }
      bf16_t* d2 = (bf16_t*)(p.ws + WS_DFT2);
      for (size_t idx = gtid; idx < (size_t)2048 * 512; idx += gsz) { const int k = (int)(idx >> 9), c8 = (int)(idx & 511) * 8; float v[8];
#pragma unroll
          for (int e = 0; e < 8; ++e) { const int col = c8 + e, s = col & 2047, j = (k * s) & 2047; const float x = (float)j * (1.0f / 1024.0f); v[e] = (col >> 11) ? -sinpif(x) : cospif(x); }
          u32x4 w; w.x = cvt_pk_bf16(v[0], v[1]); w.y = cvt_pk_bf16(v[2], v[3]); w.z = cvt_pk_bf16(v[4], v[5]); w.w = cvt_pk_bf16(v[6], v[7]);
          *(u32x4*)(d2 + (size_t)k * 4096 + c8) = w; } }
    { const f32x4* xp = (const f32x4*)p.in[0]; const f32x4* xs = (const f32x4*)p.in[1]; f32x4* xo = (f32x4*)p.out; u32x2* xb = (u32x2*)(p.ws + WS_XB);
      for (size_t idx = gtid; idx < (size_t)T * 256; idx += gsz) { const f32x4 v = idx < (size_t)TP * 256 ? xp[idx] : xs[idx - (size_t)TP * 256]; xo[idx] = v;
          u32x2 w; w.x = cvt_pk_bf16(v[0], v[1]); w.y = cvt_pk_bf16(v[2], v[3]); xb[idx] = w; } }
}

__device__ __forceinline__ void phase_ln(const Params& p, int l, int which) {
    const Lane L = get_lane();
    const float* g = p.in[2] + (size_t)(l * 3 + which) * 1024; const float* b = p.in[3] + (size_t)(l * 3 + which) * 1024;
    f32x4 gv[4], bv[4];
#pragma unroll
    for (int j = 0; j < 4; ++j) { gv[j] = *(const f32x4*)(g + j * 256 + L.lane * 4); bv[j] = *(const f32x4*)(b + j * 256 + L.lane * 4); }
    bf16_t* xb = (bf16_t*)(p.ws + WS_XB);
    for (int row = L.bid * 8 + L.wid; row < T; row += gridDim.x * 8) {
        float* rp = p.out + (size_t)row * 1024 + L.lane * 4; f32x4 v[4]; float s = 0.f;
#pragma unroll
        for (int j = 0; j < 4; ++j) { v[j] = *(const f32x4*)(rp + j * 256); s += (v[j][0] + v[j][1]) + (v[j][2] + v[j][3]); }
        const float mean = wave_sum(s, L.lane) * (1.0f / 1024.0f); float q = 0.f;
#pragma unroll
        for (int j = 0; j < 4; ++j) { const f32x4 d = v[j] - mean; q += (d[0] * d[0] + d[1] * d[1]) + (d[2] * d[2] + d[3] * d[3]); }
        const float rstd = rsqrtf(wave_sum(q, L.lane) * (1.0f / 1024.0f) + LN_EPS);
#pragma unroll
        for (int j = 0; j < 4; ++j) { const f32x4 o = (v[j] - mean) * rstd * gv[j] + bv[j]; *(f32x4*)(rp + j * 256) = o;
            u32x2 w; w.x = cvt_pk_bf16(o[0], o[1]); w.y = cvt_pk_bf16(o[2], o[3]); *(u32x2*)(xb + (size_t)row * 1024 + j * 256 + L.lane * 4) = w; }
    }
}

__device__ __forceinline__ u32x4 pack8(const f32x4& a, const f32x4& b) { u32x4 w; w.x = cvt_pk_bf16(a[0], a[1]); w.y = cvt_pk_bf16(a[2], a[3]); w.z = cvt_pk_bf16(b[0], b[1]); w.w = cvt_pk_bf16(b[2], b[3]); return w; }

__device__ __forceinline__ void phase_ffn_up(const Params& p, LAS unsigned char* lds, int l, int f) {
    const Lane L = get_lane();
    const bf16_t* xb = (const bf16_t*)(p.ws + WS_XB); const bf16_t* W = (const bf16_t*)(p.ws + WS_W + (size_t)l * W_LAYER + W_UP) + (size_t)f * 5632 * 1024; bf16_t* H = (bf16_t*)(p.ws + WS_H);
    const int G = gridDim.x, bid = L.bid;
    auto next = [=](int i, GU& u) -> bool { int pm, pn; if (!tile_order(i * G + bid, 320, 22, pm, pn)) return false;
        u.A = (const char*)(xb + (size_t)pm * 256 * 1024); u.B = (const char*)(W + (size_t)pn * 256 * 1024); u.pm = pm; u.pn = pn; return true; };
    auto epi = [=](f32x4 (&acc)[2][2][4][2], const GU& u) {
        const int row0 = u.pm * 256 + L.wr * 64 + L.fr, col0 = u.pn * 128 + L.wc * 32 + 8 * L.fq;
#pragma unroll
        for (int ai = 0; ai < 2; ++ai)
#pragma unroll
            for (int m = 0; m < 4; ++m) { f32x4 o[2];
#pragma unroll
                for (int n = 0; n < 2; ++n)
#pragma unroll
                    for (int j = 0; j < 4; ++j) o[n][j] = silu_f(acc[ai][0][m][n][j]) * acc[ai][1][m][n][j];
                *(u32x4*)(H + (size_t)(row0 + ai * 128 + m * 16) * DFF + col0) = pack8(o[0], o[1]); }
    };
    gemm_stream<true>(L, lds, 1024, next, epi);
}

__device__ __forceinline__ void phase_down(const Params& p, LAS unsigned char* lds, const bf16_t* A, int K, const bf16_t* W, float cscale) {
    const Lane L = get_lane();
    const int G = gridDim.x, bid = L.bid; float* out = p.out;
    auto next = [=](int i, GU& u) -> bool { int pm, pn; if (!tile_order(i * G + bid, 320, 4, pm, pn)) return false;
        u.A = (const char*)(A + (size_t)pm * 256 * K); u.B = (const char*)(W + (size_t)pn * 256 * K); u.pm = pm; u.pn = pn; return true; };
    auto epi = [=](f32x4 (&acc)[2][2][4][2], const GU& u) {
        const int row0 = u.pm * 256 + L.wr * 64 + L.fr, col0 = u.pn * 256 + L.wc * 32 + 4 * L.fq;
#pragma unroll
        for (int ai = 0; ai < 2; ++ai)
#pragma unroll
            for (int m = 0; m < 4; ++m) { float* rp = out + (size_t)(row0 + ai * 128 + m * 16) * 1024 + col0;
#pragma unroll
                for (int bj = 0; bj < 2; ++bj)
#pragma unroll
                    for (int n = 0; n < 2; ++n) { const f32x4 x = *(const f32x4*)(rp + bj * 128 + n * 16); *(f32x4*)(rp + bj * 128 + n * 16) = x * ALPHA + acc[ai][bj][m][n] * cscale; }
                asm volatile("" ::: "memory"); }
    };
    gemm_stream<false>(L, lds, K, next, epi);
}

__device__ __forceinline__ void phase_mix_in(const Params& p, LAS unsigned char* lds, int l) {
    const Lane L = get_lane();
    const bf16_t* xb = (const bf16_t*)(p.ws + WS_XB); const unsigned char* wl = p.ws + WS_W + (size_t)l * W_LAYER;
    const bf16_t* Win = (const bf16_t*)(wl + W_IN); const bf16_t* Wf = (const bf16_t*)(wl + W_F);
    bf16_t* Z = (bf16_t*)(p.ws + WS_Z); bf16_t* ZT = (bf16_t*)(p.ws + WS_ZT);
    const int G = gridDim.x, bid = L.bid;
    {
        auto next = [=](int i, GU& u) -> bool { int pm, pn; if (!tile_order(i * G + bid, 320, 6, pm, pn)) return false;
            u.A = (const char*)(xb + (size_t)pm * 256 * 1024); u.B = (const char*)(Win + (size_t)pn * 256 * 1024); u.pm = pm; u.pn = pn; return true; };
        auto epi = [=](f32x4 (&acc)[2][2][4][2], const GU& u) {
            const int row0 = u.pm * 256 + L.wr * 64 + L.fr, col0 = u.pn * 256 + L.wc * 32 + 8 * L.fq; const bool act = (u.pn == 3 || u.pn == 4);
#pragma unroll
            for (int ai = 0; ai < 2; ++ai)
#pragma unroll
                for (int m = 0; m < 4; ++m)
#pragma unroll
                    for (int bj = 0; bj < 2; ++bj) { f32x4 o0 = acc[ai][bj][m][0], o1 = acc[ai][bj][m][1];
                        if (act) {
#pragma unroll
                            for (int j = 0; j < 4; ++j) { o0[j] = gelu_tanh(o0[j]); o1[j] = gelu_tanh(o1[j]); } }
                        *(u32x4*)(Z + (size_t)(row0 + ai * 128 + m * 16) * 1536 + col0 + bj * 128) = pack8(o0, o1); }
        };
        gemm_stream<true>(L, lds, 1024, next, epi);
    }
    {
        auto next = [=](int i, GU& u) -> bool { int pm, pn; if (!tile_order(i * G + bid, 320, 2, pm, pn)) return false;
            u.A = (const char*)(Wf + (size_t)pn * 256 * 1024); u.B = (const char*)(xb + (size_t)pm * 256 * 1024); u.pm = pm; u.pn = pn; return true; };
        auto epi = [=](f32x4 (&acc)[2][2][4][2], const GU& u) {
            const int tok0 = u.pm * 256, part = u.pn;
            size_t base; int S;
            if (tok0 < TP) { S = 4096; base = (size_t)(tok0 >> 12) * 256 * 2 * 4096 + (tok0 & 4095); }
            else { S = 2048; const int t2 = tok0 - TP; base = (size_t)TP * 512 + (size_t)(t2 >> 11) * 256 * 2 * 2048 + (t2 & 2047); }
#pragma unroll
            for (int ai = 0; ai < 2; ++ai)
#pragma unroll
                for (int m = 0; m < 4; ++m) { const int colc = ai * 128 + L.wr * 64 + m * 16 + L.fr;
#pragma unroll
                    for (int bj = 0; bj < 2; ++bj)
                        *(u32x4*)(ZT + base + (size_t)(colc * 2 + part) * S + bj * 128 + L.wc * 32 + 8 * L.fq) = pack8(acc[ai][bj][m][0], acc[ai][bj][m][1]); }
        };
        gemm_stream<true>(L, lds, 1024, next, epi);
    }
}

__device__ __forceinline__ void phase_dft(const Params& p, LAS unsigned char* lds) {
    const Lane L = get_lane();
    const bf16_t* ZT = (const bf16_t*)(p.ws + WS_ZT); bf16_t* BR1 = (bf16_t*)(p.ws + WS_BR) + (size_t)1 * T * 256;
    const bf16_t* D4 = (const bf16_t*)(p.ws + WS_DFT4); const bf16_t* D2 = (const bf16_t*)(p.ws + WS_DFT2);
    const int G = gridDim.x, bid = L.bid;
    {
        auto next = [=](int i, GU& u) -> bool { const int v = i * G + bid; if (v >= 256) return false; const int b = v >> 4, pm = v & 15;
            u.A = (const char*)(D4 + (size_t)pm * 256 * 8192); u.B = (const char*)(ZT + (size_t)b * 256 * 8192); u.pm = b * 4096 + pm * 256; u.pn = 0; return true; };
        auto epi = [=](f32x4 (&acc)[2][2][4][2], const GU& u) {
            const int row0 = u.pm + L.wr * 64 + L.fr, col0 = L.wc * 32 + 8 * L.fq; const float scale = 1.0f / 512.0f;
#pragma unroll
            for (int ai = 0; ai < 2; ++ai)
#pragma unroll
                for (int m = 0; m < 4; ++m)
#pragma unroll
                    for (int bj = 0; bj < 2; ++bj)
                        *(u32x4*)(BR1 + (size_t)(row0 + ai * 128 + m * 16) * 256 + col0 + bj * 128) = pack8(acc[ai][bj][m][0] * scale, acc[ai][bj][m][1] * scale);
        };
        gemm_stream<true>(L, lds, 8192, next, epi);
    }
    {
        auto next = [=](int i, GU& u) -> bool { const int v = i * G + (G - 1 - bid); if (v >= 64) return false; const int b = v >> 3, pm = v & 7;
            u.A = (const char*)(D2 + (size_t)pm * 256 * 4096); u.B = (const char*)(ZT + (size_t)TP * 512 + (size_t)b * 256 * 4096); u.pm = TP + b * 2048 + pm * 256; u.pn = 0; return true; };
        auto epi = [=](f32x4 (&acc)[2][2][4][2], const GU& u) {
            const int row0 = u.pm + L.wr * 64 + L.fr, col0 = L.wc * 32 + 8 * L.fq; const float scale = 0.00276213586400995f;
#pragma unroll
            for (int ai = 0; ai < 2; ++ai)
#pragma unroll
                for (int m = 0; m < 4; ++m)
#pragma unroll
                    for (int bj = 0; bj < 2; ++bj)
                        *(u32x4*)(BR1 + (size_t)(row0 + ai * 128 + m * 16) * 256 + col0 + bj * 128) = pack8(acc[ai][bj][m][0] * scale, acc[ai][bj][m][1] * scale);
        };
        gemm_stream<true>(L, lds, 4096, next, epi);
    }
}

__device__ __forceinline__ void phase_mixers(const Params& p, LAS unsigned char* lds, int l) {
    const Lane L = get_lane(); const int tid = L.tid;
    const bf16_t* Z = (const bf16_t*)(p.ws + WS_Z);
    bf16_t* BR0 = (bf16_t*)(p.ws + WS_BR); bf16_t* BR2 = BR0 + (size_t)2 * T * 256; bf16_t* BR3 = BR0 + (size_t)3 * T * 256;
    const size_t gtid = (size_t)L.bid * NTHREADS + tid, gsz = (size_t)gridDim.x * NTHREADS;
    const float* cw = p.in[8] + (size_t)l * 3 * 256;
    for (size_t idx = gtid; idx < (size_t)T * 32; idx += gsz) {
        const int t = (int)(idx >> 5), c8 = (int)(idx & 31) * 8; int s, S; if (t < TP) { s = t & 4095; S = 4096; } else { s = (t - TP) & 2047; S = 2048; }
        const bf16_t* zr = Z + (size_t)t * 1536 + c8;
        { const u32x4 hv = *(const u32x4*)zr, gb = *(const u32x4*)(zr + 256), gc = *(const u32x4*)(zr + 512);
          u32x4 hp = (u32x4){0u, 0u, 0u, 0u}, cp = hp, hn = hp, cn = hp;
          if (s > 0) { hp = *(const u32x4*)(zr - 1536); cp = *(const u32x4*)(zr - 1536 + 512); }
          if (s + 1 < S) { hn = *(const u32x4*)(zr + 1536); cn = *(const u32x4*)(zr + 1536 + 512); }
          const f32x4 w0a = *(const f32x4*)(cw + c8), w0b = *(const f32x4*)(cw + c8 + 4), w1a = *(const f32x4*)(cw + 256 + c8), w1b = *(const f32x4*)(cw + 256 + c8 + 4), w2a = *(const f32x4*)(cw + 512 + c8), w2b = *(const f32x4*)(cw + 512 + c8 + 4);
          float o[8];
#pragma unroll
          for (int e = 0; e < 4; ++e) {
              const float k0l = e < 2 ? w0a[2 * e] : w0b[2 * e - 4], k0h = e < 2 ? w0a[2 * e + 1] : w0b[2 * e - 3];
              const float k1l = e < 2 ? w1a[2 * e] : w1b[2 * e - 4], k1h = e < 2 ? w1a[2 * e + 1] : w1b[2 * e - 3];
              const float k2l = e < 2 ? w2a[2 * e] : w2b[2 * e - 4], k2h = e < 2 ? w2a[2 * e + 1] : w2b[2 * e - 3];
              o[2 * e] = bflo(gb[e]) * (k0l * bflo(cp[e]) * bflo(hp[e]) + k1l * bflo(gc[e]) * bflo(hv[e]) + k2l * bflo(cn[e]) * bflo(hn[e]));
              o[2 * e + 1] = bfhi(gb[e]) * (k0h * bfhi(cp[e]) * bfhi(hp[e]) + k1h * bfhi(gc[e]) * bfhi(hv[e]) + k2h * bfhi(cn[e]) * bfhi(hn[e])); }
          u32x4 w; w.x = cvt_pk_bf16(o[0], o[1]); w.y = cvt_pk_bf16(o[2], o[3]); w.z = cvt_pk_bf16(o[4], o[5]); w.w = cvt_pk_bf16(o[6], o[7]);
          *(u32x4*)(BR0 + (size_t)t * 256 + c8) = w; }
        { const int half = 1 << (c8 >> 6); const int lo = s - half < 0 ? 0 : s - half, hi = s + half > S ? S : s + half;
          float sum[8];
#pragma unroll
          for (int e = 0; e < 8; ++e) sum[e] = 0.f;
          for (int j = lo; j < hi; ++j) { const u32x4 v = *(const u32x4*)(zr + 1280 + (ptrdiff_t)(j - s) * 1536);
#pragma unroll
              for (int e = 0; e < 4; ++e) { sum[2 * e] += bflo(v[e]); sum[2 * e + 1] += bfhi(v[e]); } }
          const float inv = 1.0f / (float)(hi - lo); const u32x4 zc = *(const u32x4*)(zr + 1280);
          u32x4 w;
#pragma unroll
          for (int e = 0; e < 4; ++e) w[e] = cvt_pk_bf16(sum[2 * e] * inv - bflo(zc[e]), sum[2 * e + 1] * inv - bfhi(zc[e]));
          *(u32x4*)(BR3 + (size_t)t * 256 + c8) = w; }
    }
    LAS bf16_t* VT = (LAS bf16_t*)lds;
    LAS float* red = (LAS float*)(lds + 69632);
    const float* lg = p.in[9] + (size_t)l * 256; const float* lb = p.in[10] + (size_t)l * 256;
    const float* sw = p.in[11] + (size_t)l * 4 * 128 * 128; const float* sb = p.in[12] + (size_t)l * 4 * 128;
    for (int ch = L.bid; ch < T / 128; ch += gridDim.x) {
        const int t0 = ch * 128, q = tid & 127, part = tid >> 7;
        const bf16_t* vp = Z + (size_t)(t0 + q) * 1536 + 1024 + part * 64;
        __syncthreads();
        float s = 0.f, ss = 0.f;
#pragma unroll
        for (int j = 0; j < 8; ++j) { const u32x4 w = *(const u32x4*)(vp + j * 8);
#pragma unroll
            for (int e = 0; e < 4; ++e) { const float a = bflo(w[e]), b = bfhi(w[e]); s += a + b; ss += a * a + b * b; } }
        red[(part * 128 + q) * 2] = s; red[(part * 128 + q) * 2 + 1] = ss;
        __syncthreads();
        float S1 = 0.f, S2 = 0.f;
#pragma unroll
        for (int pp = 0; pp < 4; ++pp) { S1 += red[(pp * 128 + q) * 2]; S2 += red[(pp * 128 + q) * 2 + 1]; }
        const float mean = S1 * (1.0f / 256.0f), var = S2 * (1.0f / 256.0f) - mean * mean, rstd = rsqrtf((var > 0.f ? var : 0.f) + LN_EPS);
#pragma unroll
        for (int j = 0; j < 8; ++j) { const u32x4 w = *(const u32x4*)(vp + j * 8); const int c0 = part * 64 + j * 8;
#pragma unroll
            for (int e = 0; e < 4; ++e) { const float a = (bflo(w[e]) - mean) * rstd * lg[c0 + 2 * e] + lb[c0 + 2 * e], b = (bfhi(w[e]) - mean) * rstd * lg[c0 + 2 * e + 1] + lb[c0 + 2 * e + 1];
                VT[(c0 + 2 * e) * 136 + q] = f2bf(a); VT[(c0 + 2 * e + 1) * 136 + q] = f2bf(b); } }
        __syncthreads();
        const int hh = L.wid >> 1, ph = L.wid & 1;
        f32x4 a2[4][4];
#pragma unroll
        for (int ct = 0; ct < 4; ++ct)
#pragma unroll
            for (int pt = 0; pt < 4; ++pt) a2[ct][pt] = (f32x4){0.f, 0.f, 0.f, 0.f};
#pragma unroll
        for (int ks = 0; ks < 4; ++ks) {
            bf16x8 wf[4];
#pragma unroll
            for (int pt = 0; pt < 4; ++pt) { const float* wp = sw + ((size_t)(hh * 128 + ph * 64 + pt * 16 + L.fr) * 128 + ks * 32 + L.fq * 8);
                const f32x4 w0 = *(const f32x4*)wp, w1 = *(const f32x4*)(wp + 4); wf[pt] = __builtin_bit_cast(bf16x8, pack8(w0, w1)); }
#pragma unroll
            for (int ct = 0; ct < 4; ++ct) { const bf16x8 vf = *(const LAS bf16x8*)(VT + (hh * 64 + ct * 16 + L.fr) * 136 + ks * 32 + L.fq * 8);
#pragma unroll
                for (int pt = 0; pt < 4; ++pt) a2[ct][pt] = __builtin_amdgcn_mfma_f32_16x16x32_bf16(vf, wf[pt], a2[ct][pt], 0, 0, 0); }
        }
#pragma unroll
        for (int pt = 0; pt < 4; ++pt) { const int pp = ph * 64 + pt * 16 + L.fr, t = t0 + pp; const float bias = sb[hh * 128 + pp];
#pragma unroll
            for (int ct = 0; ct < 4; ++ct) { const int c = hh * 64 + ct * 16 + 4 * L.fq; const u32x2 u = *(const u32x2*)(Z + (size_t)t * 1536 + 768 + c);
                u32x2 w; w.x = cvt_pk_bf16(bflo(u.x) * (a2[ct][pt][0] + bias), bfhi(u.x) * (a2[ct][pt][1] + bias)); w.y = cvt_pk_bf16(bflo(u.y) * (a2[ct][pt][2] + bias), bfhi(u.y) * (a2[ct][pt][3] + bias));
                *(u32x2*)(BR2 + (size_t)t * 256 + c) = w; } }
    }
}

__device__ __forceinline__ void phase_gate_branch(const Params& p, LAS unsigned char* lds, int l) {
    const Lane L = get_lane();
    const bf16_t* xb = (const bf16_t*)(p.ws + WS_XB); const unsigned char* wl = p.ws + WS_W + (size_t)l * W_LAYER;
    const bf16_t* Wg = (const bf16_t*)(wl + W_G); const bf16_t* Wb = (const bf16_t*)(wl + W_B); const bf16_t* BR = (const bf16_t*)(p.ws + WS_BR);
    const float* bg = p.in[16] + (size_t)l * 4 * 1024; bf16_t* MRG = (bf16_t*)(p.ws + WS_MRG);
    unsigned char* scr = p.ws + WS_SCR + (size_t)L.bid * 393216;
    for (int it = 0;; ++it) { int pm, pn; if (!tile_order(it * gridDim.x + L.bid, 320, 4, pm, pn)) break;
#pragma unroll 1
        for (int i = 0; i < 4; ++i) {
            {
                auto next = [=](int k, GU& u) -> bool { if (k > 0) return false; u.A = (const char*)(xb + (size_t)pm * 256 * 1024); u.B = (const char*)(Wg + (size_t)(i * 1024 + pn * 256) * 1024); u.pm = pm; u.pn = pn; return true; };
                auto epi = [=](f32x4 (&acc)[2][2][4][2], const GU& u) {
                    unsigned loff = (unsigned)L.tid * 16u; asm volatile("" : "+v"(loff));
                    const int col0 = u.pn * 256 + L.wc * 32 + 8 * L.fq;
#pragma unroll
                    for (int bj = 0; bj < 2; ++bj) { const f32x4 b0 = *(const f32x4*)(bg + i * 1024 + col0 + bj * 128), b1 = *(const f32x4*)(bg + i * 1024 + col0 + bj * 128 + 4);
#pragma unroll
                        for (int ai = 0; ai < 2; ++ai)
#pragma unroll
                            for (int m = 0; m < 4; ++m) { f32x4 g0 = acc[ai][bj][m][0] + b0, g1 = acc[ai][bj][m][1] + b1;
#pragma unroll
                                for (int j = 0; j < 4; ++j) { g0[j] = sigmoid_f(g0[j]); g1[j] = sigmoid_f(g1[j]); }
                                *(u32x4*)(scr + (loff + (unsigned)(((ai * 2 + bj) * 4 + m) * 8192))) = pack8(g0, g1); asm volatile("" ::: "memory"); __builtin_amdgcn_sched_barrier(0); } }
                };
                gemm_stream<true>(L, lds, 1024, next, epi);
            }
            {
                auto next = [=](int k, GU& u) -> bool { if (k > 0) return false; u.A = (const char*)(BR + ((size_t)i * T + (size_t)pm * 256) * 256); u.B = (const char*)(Wb + ((size_t)i * 1024 + pn * 256) * 256); u.pm = pm; u.pn = pn; return true; };
                auto epi = [=](f32x4 (&acc)[2][2][4][2], const GU& u) {
                    unsigned loff = (unsigned)L.tid * 16u; asm volatile("" : "+v"(loff));
                    int row0o = u.pm * 256 + L.wr * 64 + L.fr; asm volatile("" : "+v"(row0o));
                    const int col0 = u.pn * 256 + L.wc * 32 + 8 * L.fq;
#pragma unroll
                    for (int ai = 0; ai < 2; ++ai)
#pragma unroll
                        for (int bj = 0; bj < 2; ++bj)
#pragma unroll
                            for (int m = 0; m < 4; ++m) { const int slot = (ai * 2 + bj) * 4 + m; const u32x4 g = *(const u32x4*)(scr + (loff + (unsigned)(slot * 8192)));
                                f32x4 v0 = acc[ai][bj][m][0] * (f32x4){bflo(g.x), bfhi(g.x), bflo(g.y), bfhi(g.y)}, v1 = acc[ai][bj][m][1] * (f32x4){bflo(g.z), bfhi(g.z), bflo(g.w), bfhi(g.w)};
                                if (i > 0) { v0 += *(const f32x4*)(scr + (loff + (unsigned)(131072 + (slot * 2) * 8192))); v1 += *(const f32x4*)(scr + (loff + (unsigned)(131072 + (slot * 2 + 1) * 8192))); }
                                if (i < 3) { *(f32x4*)(scr + (loff + (unsigned)(131072 + (slot * 2) * 8192))) = v0; *(f32x4*)(scr + (loff + (unsigned)(131072 + (slot * 2 + 1) * 8192))) = v1; }
                                else *(u32x4*)(MRG + (size_t)(row0o + ai * 128 + m * 16) * 1024 + col0 + bj * 128) = pack8(v0, v1);
                                asm volatile("" ::: "memory"); __builtin_amdgcn_sched_barrier(0); }
                };
                gemm_stream<true>(L, lds, 256, next, epi);
            }
        }
    }
}

__device__ __forceinline__ void grid_barrier(unsigned* ctr, unsigned target) {
    __syncthreads();
    if (threadIdx.x == 0) {
        __builtin_amdgcn_fence(__ATOMIC_RELEASE, "agent");
        __hip_atomic_fetch_add(ctr, 1u, __ATOMIC_RELAXED, __HIP_MEMORY_SCOPE_AGENT);
        while (__hip_atomic_load(ctr, __ATOMIC_RELAXED, __HIP_MEMORY_SCOPE_AGENT) < target) __builtin_amdgcn_s_sleep(1);
        __builtin_amdgcn_fence(__ATOMIC_ACQUIRE, "agent");
    }
    __syncthreads();
}

__global__ void __launch_bounds__(NTHREADS, 2) fwd_kernel(Params p) {
    extern __shared__ __attribute__((aligned(16))) unsigned char lds_raw[];
    LAS unsigned char* lds = (LAS unsigned char*)lds_raw;
    cg::grid_group grid = cg::this_grid();
    unsigned* bar = (unsigned*)p.ws;
    if (blockIdx.x == 0 && threadIdx.x == 0) __hip_atomic_store(bar, 0u, __ATOMIC_RELAXED, __HIP_MEMORY_SCOPE_AGENT);
    for (int ph = p.ph_lo; ph < p.ph_hi; ++ph) {
        if (ph == p.ph_lo + 1) grid.sync();
        else if (ph > p.ph_lo + 1) grid_barrier(bar, (unsigned)(ph - p.ph_lo - 1) * gridDim.x);
        if (ph == 0) { phase_prep(p, lds); continue; }
        const int l = (ph - 1) / 11, s = (ph - 1) % 11;
        const unsigned char* wl = p.ws + WS_W + (size_t)l * W_LAYER;
        if (s == 0 || s == 8) phase_ffn_up(p, lds, l, s == 0 ? 0 : 1);
        else if (s == 1 || s == 9) phase_down(p, lds, (const bf16_t*)(p.ws + WS_H), DFF, (const bf16_t*)(wl + W_DN) + (size_t)(s == 1 ? 0 : 1) * 1024 * DFF, 0.5f);
        else if (s == 2 || s == 7 || s == 10) phase_ln(p, l, s == 2 ? 0 : (s == 7 ? 1 : 2));
        else if (s == 3) phase_mix_in(p, lds, l);
        else if (s == 4) { phase_dft(p, lds); __syncthreads(); phase_mixers(p, lds, l); }
        else if (s == 5) phase_gate_branch(p, lds, l);
        else if (s == 6) phase_down(p, lds, (const bf16_t*)(p.ws + WS_MRG), 1024, (const bf16_t*)(wl + W_O), 1.0f);
        __syncthreads();
    }
}

extern "C" void kernel_launch(void* const* d_in, const int* in_sizes, int n_in, void* d_out, int out_size, void* d_ws, size_t ws_size, hipStream_t stream) {
    static int grid = 0;
    if (grid == 0) {
        if (n_in != 19 || out_size != T * D || ws_size < WS_END) { fprintf(stderr, "kernel_launch: unexpected shapes (n_in %d, out %d, ws %zu)\n", n_in, out_size, ws_size); grid = -1; return; }
        int dev = 0, cus = 0, per_cu = 0;
        hipGetDevice(&dev); hipDeviceGetAttribute(&cus, hipDeviceAttributeMultiprocessorCount, dev);
        if (hipFuncSetAttribute((const void*)fwd_kernel, hipFuncAttributeMaxDynamicSharedMemorySize, LDS_BYTES) != hipSuccess) { fprintf(stderr, "kernel_launch: hipFuncSetAttribute failed\n"); grid = -1; return; }
        if (hipOccupancyMaxActiveBlocksPerMultiprocessor(&per_cu, (const void*)fwd_kernel, NTHREADS, LDS_BYTES) != hipSuccess || per_cu < 1) { fprintf(stderr, "kernel_launch: occupancy query says %d\n", per_cu); per_cu = 1; }
        (void)hipGetLastError();
        grid = cus * 1;
        fprintf(stderr, "kernel_launch: grid %d (cus %d, per_cu %d), ws %zu\n", grid, cus, per_cu, ws_size);
    }
    if (grid < 0) return;
    Params p{};
    for (int i = 0; i < 19; ++i) p.in[i] = (const float*)d_in[i];
    p.out = (float*)d_out; p.ws = (unsigned char*)d_ws;
#if N_LAUNCH_PER_PHASE
    for (int ph = 0; ph < NPHASE; ++ph) { p.ph_lo = ph; p.ph_hi = ph + 1; hipLaunchKernelGGL(fwd_kernel, dim3(grid), dim3(NTHREADS), LDS_BYTES, stream, p); }
#else
    p.ph_lo = 0; p.ph_hi = NPHASE;
    void* args[] = {&p};
    hipError_t e = hipLaunchCooperativeKernel((const void*)fwd_kernel, dim3(grid), dim3(NTHREADS), args, LDS_BYTES, stream);
    if (e != hipSuccess) fprintf(stderr, "cooperative launch failed: %s (grid %d)\n", hipGetErrorString(e), grid);
#endif
}
```

```cpp
#include <hip/hip_runtime.h>
#include <hip/hip_cooperative_groups.h>
#include <cstdio>
namespace cg = cooperative_groups;

#ifndef N_LAUNCH_PER_PHASE
#define N_LAUNCH_PER_PHASE 0
#endif

#define LAS __attribute__((address_space(3)))
typedef unsigned short bf16_t;
typedef short bf16x8 __attribute__((ext_vector_type(8)));
typedef float f32x4 __attribute__((ext_vector_type(4)));
typedef unsigned u32x4 __attribute__((ext_vector_type(4)));
typedef unsigned u32x2 __attribute__((ext_vector_type(2)));

constexpr int T = 81920, TP = 65536, D = 1024, DFF = 2816;
constexpr int NTHREADS = 512;
constexpr int LDS_BYTES = 147456;
constexpr int HTB = 16384;
constexpr float ALPHA = 1.41421356237309515f;
constexpr float LN_EPS = 1e-5f;

constexpr size_t MiB = 1ull << 20;
constexpr size_t WS_W = 1 * MiB;
constexpr size_t W_UP = 0;
constexpr size_t W_DN = 22 * MiB;
constexpr size_t W_IN = 33 * MiB;
constexpr size_t W_G = 36 * MiB;
constexpr size_t W_F = 44 * MiB;
constexpr size_t W_B = 45 * MiB;
constexpr size_t W_O = 47 * MiB;
constexpr size_t W_LAYER = 49 * MiB;
constexpr size_t WS_DFT4 = 99 * MiB;
constexpr size_t WS_DFT2 = 163 * MiB;
constexpr size_t WS_XB = 179 * MiB;
constexpr size_t WS_R = 339 * MiB;
constexpr size_t WS_H = WS_R;
constexpr size_t WS_Z = WS_R;
constexpr size_t WS_MRG = WS_R;
constexpr size_t WS_ZT = WS_R + 240 * MiB;
constexpr size_t WS_BR = WS_R + 320 * MiB;
constexpr size_t WS_SCR = WS_R + 480 * MiB;
constexpr size_t WS_XCH = 915 * MiB;
constexpr size_t WS_END = 918 * MiB;
constexpr size_t CTL_CNT = 4096;
constexpr int NPHASE = 19;

struct Params { const float* in[19]; float* out; unsigned char* ws; int ph_lo, ph_hi; };

typedef _Float16 h16x2_t __attribute__((ext_vector_type(2)));
typedef _Float16 h16x8_t __attribute__((ext_vector_type(8)));
typedef float f32x2_t __attribute__((ext_vector_type(2)));
__device__ __forceinline__ unsigned cvt_pk_bf16(float lo, float hi) { const f32x2_t v = {lo, hi}; return __builtin_bit_cast(unsigned, __builtin_convertvector(v, h16x2_t)); }
__device__ __forceinline__ bf16_t f2bf(float f) { return __builtin_bit_cast(unsigned short, (_Float16)f); }
__device__ __forceinline__ float bflo(unsigned w) { return (float)__builtin_bit_cast(h16x2_t, w).x; }
__device__ __forceinline__ float bfhi(unsigned w) { return (float)__builtin_bit_cast(h16x2_t, w).y; }
typedef __bf16 tb16x2_t __attribute__((ext_vector_type(2)));
__device__ __forceinline__ unsigned cvt_pk_tb16(float lo, float hi) { const f32x2_t v = {lo, hi}; return __builtin_bit_cast(unsigned, __builtin_convertvector(v, tb16x2_t)); }
__device__ __forceinline__ float tblo(unsigned w) { return __uint_as_float(w << 16); }
__device__ __forceinline__ float tbhi(unsigned w) { return __uint_as_float(w & 0xffff0000u); }
__device__ __forceinline__ float sigmoid_f(float x) { return __builtin_amdgcn_rcpf(1.0f + __expf(-x)); }
__device__ __forceinline__ float gelu_tanh(float x) { return x * sigmoid_f(1.5957691216057308f * (x + 0.044715f * x * x * x)); }
__device__ __forceinline__ float silu_f(float x) { return x * sigmoid_f(x); }
__device__ __forceinline__ float wave_sum(float v, int lane) {
#pragma unroll
    for (int o = 32; o >= 1; o >>= 1) v += __int_as_float(__builtin_amdgcn_ds_bpermute((lane ^ o) << 2, __float_as_int(v)));
    return v;
}

__device__ __forceinline__ int lds_byte(int r, int c) { const int st = (r >> 4) * 2 + (c >> 5), rr = r & 15, cc = c & 31, ob = rr * 64 + cc * 2; return st * 1024 + (ob ^ (((ob >> 9) & 1) << 5)); }
__device__ __forceinline__ void stage_rc(int b, int& R, int& C) { const int st = b / 1024, sb = b % 1024, swz = sb ^ (((sb >> 9) & 1) << 5); R = (st >> 1) * 16 + swz / 64; C = (st & 1) * 32 + (swz % 64) / 2; }
__device__ __forceinline__ int perm32(int rho) { const int n = rho >> 4, i = rho & 15; return 8 * (i >> 2) + 4 * n + (i & 3); }

__device__ __forceinline__ bool tile_order(int L, int nM, int nN, int& pm, int& pn) {
    const int nwg = nM * nN; if (L >= nwg) return false;
    int wgid = L; { const int q = nwg / 8, r = nwg % 8, xcd = wgid % 8, off = wgid / 8; wgid = (xcd < r ? xcd * (q + 1) : r * (q + 1) + (xcd - r) * q) + off; }
    const int nig = 8 * nN, gid = wgid / nig, fm = gid * 8, gsz = (nM - fm) < 8 ? (nM - fm) : 8;
    pm = fm + ((wgid % nig) % gsz); pn = (wgid % nig) / gsz; return true;
}

struct Lane { int tid, wid, lane, wr, wc, fr, fq, bid; };
__device__ __forceinline__ int lane_id() { int l; asm volatile("v_mbcnt_lo_u32_b32 %0, -1, 0\n\tv_mbcnt_hi_u32_b32 %0, -1, %0" : "=v"(l)); return l; }
__device__ __forceinline__ Lane get_lane(int wv) { Lane l; l.tid = wv * 64 + lane_id(); asm volatile("" : "+v"(l.tid)); l.bid = blockIdx.x; asm volatile("" : "+s"(l.bid)); l.wid = l.tid >> 6; l.lane = l.tid & 63; l.wr = l.wid >> 2; l.wc = l.wid & 3; l.fr = l.lane & 15; l.fq = l.lane >> 4; return l; }

template <bool PERM>
__device__ __forceinline__ void gemm_tile(const Lane& L, LAS unsigned char* lds, const bf16_t* __restrict__ A, int lda, const bf16_t* __restrict__ B, int ldb, int nt, f32x4 (&acc)[2][2][4][2]) {
    const int tid = L.tid, wr = L.wr, wc = L.wc, fr = L.fr, fq = L.fq;
    unsigned voffA[2], voffB[2];
#pragma unroll
    for (int i = 0; i < 2; ++i) { int R, C; stage_rc(tid * 16 + i * 8192, R, C); const int Rb = PERM ? ((R & ~31) + perm32(R & 31)) : R; voffA[i] = (unsigned)(R * lda + C) * 2u; voffB[i] = (unsigned)(Rb * ldb + C) * 2u; }
    const unsigned ldsw = (unsigned)__builtin_amdgcn_readfirstlane(tid >> 6) * 1024u;
    const int aoff = lds_byte(wr * 64 + fr, fq * 8), boff = lds_byte(wc * 32 + fr, fq * 8);
    const char* Ab = (const char*)A; const char* Bb = (const char*)B; const size_t hA = (size_t)128 * lda * 2, hB = (size_t)128 * ldb * 2;
#define GT_STAGE(sb, t) do { _Pragma("unroll") for (int _h = 0; _h < 2; ++_h) { _Pragma("unroll") for (int _i = 0; _i < 2; ++_i) { \
        __builtin_amdgcn_global_load_lds((const unsigned*)(Ab + _h * hA + (size_t)(t) * 128 + voffA[_i]), (LAS unsigned*)(lds + (sb) * 65536 + _h * HTB + ldsw + _i * 8192), 16, 0, 0); \
        __builtin_amdgcn_global_load_lds((const unsigned*)(Bb + _h * hB + (size_t)(t) * 128 + voffB[_i]), (LAS unsigned*)(lds + (sb) * 65536 + (2 + _h) * HTB + ldsw + _i * 8192), 16, 0, 0); } } } while (0)
#pragma unroll
    for (int a = 0; a < 2; ++a)
#pragma unroll
        for (int b = 0; b < 2; ++b)
#pragma unroll
            for (int m = 0; m < 4; ++m)
#pragma unroll
                for (int n = 0; n < 2; ++n) acc[a][b][m][n] = (f32x4){0.f, 0.f, 0.f, 0.f};
    { int t0 = 0; asm volatile("" : "+s"(t0)); GT_STAGE(0, t0); }
    asm volatile("s_waitcnt vmcnt(0)" ::: "memory"); __syncthreads();
    for (int t = 0; t < nt; ++t) {
        const int sb = t & 1;
        if (t + 1 < nt) { int tn = t + 1; asm volatile("" : "+s"(tn)); GT_STAGE(sb ^ 1, tn); }
        LAS unsigned char* buf = lds + sb * 65536;
#pragma unroll
        for (int ai = 0; ai < 2; ++ai) {
            __builtin_amdgcn_sched_barrier(0);
            bf16x8 At[4][2];
#pragma unroll
            for (int m = 0; m < 4; ++m)
#pragma unroll
                for (int k = 0; k < 2; ++k) At[m][k] = *(const LAS bf16x8*)(buf + ai * HTB + aoff + m * 2048 + k * 1024);
#pragma unroll
            for (int bj = 0; bj < 2; ++bj) {
                __builtin_amdgcn_sched_barrier(0);
                bf16x8 Bf[2][2];
#pragma unroll
                for (int n = 0; n < 2; ++n)
#pragma unroll
                    for (int k = 0; k < 2; ++k) Bf[n][k] = *(const LAS bf16x8*)(buf + (2 + bj) * HTB + boff + n * 2048 + k * 1024);
#pragma unroll
                for (int m = 0; m < 4; ++m)
#pragma unroll
                    for (int n = 0; n < 2; ++n)
#pragma unroll
                        for (int k = 0; k < 2; ++k) acc[ai][bj][m][n] = __builtin_amdgcn_mfma_f32_16x16x32_f16(__builtin_bit_cast(h16x8_t, Bf[n][k]), __builtin_bit_cast(h16x8_t, At[m][k]), acc[ai][bj][m][n], 0, 0, 0);
            }
        }
        asm volatile("s_waitcnt vmcnt(0)" ::: "memory"); __syncthreads();
    }
#undef GT_STAGE
}

struct GU { const char* A; const char* B; int pm, pn, K, aux; };
template <bool PERM, bool VARK, bool BF, class Next, class Epi>
__device__ __forceinline__ void gemm_stream(const Lane& L, LAS unsigned char* lds, const int K, const Next& next, const Epi& epi, f32x4 (&acc)[2][2][4][2]) {
    int tid = L.tid; asm volatile("" : "+v"(tid));
    const int wid = __builtin_amdgcn_readfirstlane(tid >> 6), wr = wid >> 2, wc = wid & 3, fr = tid & 15, fq = (tid >> 4) & 3;
    int nt = K / 64;
    unsigned voffA[2], voffB[2];
#pragma unroll
    for (int i = 0; i < 2; ++i) { int R, C; stage_rc(tid * 16 + i * 8192, R, C); const int Rb = PERM ? ((R & ~31) + perm32(R & 31)) : R; voffA[i] = (unsigned)(R * K + C) * 2u; voffB[i] = (unsigned)(Rb * K + C) * 2u; }
    const size_t kstep = 128; size_t hstep = (size_t)128 * K * 2;
    const unsigned ldsw = (unsigned)wid * 1024u;
    const int aoff = lds_byte(wr * 64 + fr, fq * 8), boff = lds_byte(wc * 32 + fr, fq * 8);
#define GS_SA(b, h) (((b) * 2 + (h)) * HTB)
#define GS_SB(b, h) ((4 + (b) * 2 + (h)) * HTB)
#define GS_STAGE(bufoff, gbase, voff) do { _Pragma("unroll") for (int _i = 0; _i < 2; ++_i) \
        __builtin_amdgcn_global_load_lds((const unsigned*)((const char*)(gbase) + (voff)[_i]), (LAS unsigned*)(lds + (bufoff) + ldsw + _i * 8192), 16, 0, 0); } while (0)
#define GS_LDA(dst, b, h) do { _Pragma("unroll") for (int m = 0; m < 4; ++m) _Pragma("unroll") for (int k = 0; k < 2; ++k) dst[m][k] = *(const LAS bf16x8*)(lds + GS_SA(b, h) + aoff + m * 2048 + k * 1024); } while (0)
#define GS_LDB(dst, b, h) do { _Pragma("unroll") for (int n = 0; n < 2; ++n) _Pragma("unroll") for (int k = 0; k < 2; ++k) dst[n][k] = *(const LAS bf16x8*)(lds + GS_SB(b, h) + boff + n * 2048 + k * 1024); } while (0)
#define GS_MMA(ai, bj, At_, Bt_) do { __builtin_amdgcn_s_setprio(1); _Pragma("unroll") for (int m = 0; m < 4; ++m) _Pragma("unroll") for (int n = 0; n < 2; ++n) _Pragma("unroll") for (int k = 0; k < 2; ++k) \
        acc[ai][bj][m][n] = BF ? __builtin_amdgcn_mfma_f32_16x16x32_bf16(Bt_[n][k], At_[m][k], acc[ai][bj][m][n], 0, 0, 0) : __builtin_amdgcn_mfma_f32_16x16x32_f16(__builtin_bit_cast(h16x8_t, Bt_[n][k]), __builtin_bit_cast(h16x8_t, At_[m][k]), acc[ai][bj][m][n], 0, 0, 0); __builtin_amdgcn_s_setprio(0); } while (0)
#define GS_WAIT_V(n) asm volatile("s_waitcnt vmcnt(" #n ")" ::: "memory")
#define GS_WAIT_L(n) asm volatile("s_waitcnt lgkmcnt(" #n ")" ::: "memory")
#define GS_BAR __builtin_amdgcn_s_barrier()
#define GS_SCHED __builtin_amdgcn_sched_barrier(0)
#define GS_ZERO() do { _Pragma("unroll") for (int a = 0; a < 2; ++a) _Pragma("unroll") for (int b = 0; b < 2; ++b) _Pragma("unroll") for (int m = 0; m < 4; ++m) _Pragma("unroll") for (int n = 0; n < 2; ++n) acc[a][b][m][n] = (f32x4){0.f, 0.f, 0.f, 0.f}; } while (0)
    GU cur, nxt; int ui = 0;
    if (!next(0, cur)) return;
    GS_ZERO();
    bf16x8 At[4][2], B0[2][2], B1[2][2];
    const char* cA = cur.A; const char* cB = cur.B;
    GS_STAGE(GS_SB(0, 0), cB, voffB); GS_STAGE(GS_SA(0, 0), cA, voffA); GS_STAGE(GS_SB(0, 1), cB + hstep, voffB); GS_STAGE(GS_SA(0, 1), cA + hstep, voffA);
    if (wr == 1) GS_BAR;
    GS_WAIT_V(4); GS_BAR;
    GS_STAGE(GS_SB(1, 0), cB + kstep, voffB); GS_STAGE(GS_SA(1, 0), cA + kstep, voffA); GS_STAGE(GS_SB(1, 1), cB + hstep + kstep, voffB);
    GS_WAIT_V(6); GS_BAR;
    for (;;) {
        const bool has_next = next(ui + 1, nxt);
        const char* nA = has_next ? nxt.A : cA; const char* nB = has_next ? nxt.B : cB;
        for (int t = 0; t < nt; t += 2) {
            const bool last = (t == nt - 2);
            const char* a1 = cA + (size_t)(t + 1) * kstep;
            const char* a2 = last ? nA : cA + (size_t)(t + 2) * kstep; const char* b2 = last ? nB : cB + (size_t)(t + 2) * kstep;
            const char* a3 = a2 + kstep; const char* b3 = b2 + kstep;
            GS_LDB(B0, 0, 0); GS_SCHED; GS_LDA(At, 0, 0); GS_STAGE(GS_SA(1, 1), a1 + hstep, voffA);
            if (VARK && last && has_next && nxt.K * 64 != nt * 4096) {
                int t2 = tid; asm volatile("" : "+v"(t2));
#pragma unroll
                for (int i = 0; i < 2; ++i) { int R, C; stage_rc(t2 * 16 + i * 8192, R, C); const int Rb = PERM ? ((R & ~31) + perm32(R & 31)) : R; voffA[i] = (unsigned)(R * nxt.K + C) * 2u; voffB[i] = (unsigned)(Rb * nxt.K + C) * 2u; }
                hstep = (size_t)128 * nxt.K * 2; }
            GS_WAIT_L(8); GS_BAR; GS_WAIT_L(0); GS_MMA(0, 0, At, B0); GS_BAR; GS_SCHED;
            GS_LDB(B1, 0, 1); GS_STAGE(GS_SB(0, 0), b2, voffB);
            GS_BAR; GS_WAIT_L(0); GS_MMA(0, 1, At, B1); GS_BAR;
            GS_LDA(At, 0, 1); GS_STAGE(GS_SA(0, 0), a2, voffA);
            GS_BAR; GS_WAIT_L(0); GS_MMA(1, 0, At, B0); GS_BAR; GS_SCHED;
            GS_STAGE(GS_SB(0, 1), b2 + hstep, voffB);
            GS_WAIT_V(6); GS_BAR; GS_MMA(1, 1, At, B1); GS_BAR;
            GS_LDB(B0, 1, 0); GS_SCHED; GS_LDA(At, 1, 0); GS_STAGE(GS_SA(0, 1), a2 + hstep, voffA);
            GS_WAIT_L(8); GS_BAR; GS_WAIT_L(0); GS_MMA(0, 0, At, B0); GS_BAR; GS_SCHED;
            GS_LDB(B1, 1, 1); GS_STAGE(GS_SB(1, 0), b3, voffB);
            GS_BAR; GS_WAIT_L(0); GS_MMA(0, 1, At, B1); GS_BAR;
            GS_LDA(At, 1, 1); GS_STAGE(GS_SA(1, 0), a3, voffA);
            GS_BAR; GS_WAIT_L(0); GS_MMA(1, 0, At, B0); GS_BAR; GS_SCHED;
            GS_STAGE(GS_SB(1, 1), b3 + hstep, voffB);
            GS_WAIT_V(6); GS_BAR; GS_MMA(1, 1, At, B1); GS_BAR;
        }
        epi(acc, cur);
        if (!has_next) break;
        GS_ZERO();
        cur = nxt; cA = nA; cB = nB; ++ui; if (VARK) nt = cur.K / 64;
    }
    GS_WAIT_V(0);
    if (wr == 0) GS_BAR;
    GS_BAR;
#undef GS_SA
#undef GS_SB
#undef GS_STAGE
#undef GS_LDA
#undef GS_LDB
#undef GS_MMA
#undef GS_WAIT_V
#undef GS_WAIT_L
#undef GS_BAR
#undef GS_SCHED
#undef GS_ZERO
}

__device__ __forceinline__ void transpose_job(const Lane& L, LAS float* tile, const float* __restrict__ src, int ld, int K, int N, bf16_t* __restrict__ dst, int dstld, int mapkind, int rowoff) {
    const int tn = N / 64, ntile = (K / 64) * tn;
    for (int tl = L.bid; tl < ntile; tl += gridDim.x) {
        const int k0 = (tl / tn) * 64, n0 = (tl % tn) * 64;
        __syncthreads();
#pragma unroll
        for (int h = 0; h < 2; ++h) { const int e = L.tid + h * NTHREADS, r = e >> 4, c4 = (e & 15) * 4; const f32x4 v = *(const f32x4*)(src + (size_t)(k0 + r) * ld + n0 + c4);
            tile[r * 65 + c4] = v[0]; tile[r * 65 + c4 + 1] = v[1]; tile[r * 65 + c4 + 2] = v[2]; tile[r * 65 + c4 + 3] = v[3]; }
        __syncthreads();
        { const int r = L.tid >> 3, c8 = (L.tid & 7) * 8, n = n0 + r;
          const int drow = (mapkind & 3) == 0 ? rowoff + n : ((n >> 7) * 256 + rowoff + (n & 127));
          float v[8];
#pragma unroll
          for (int j = 0; j < 8; ++j) v[j] = tile[(c8 + j) * 65 + r];
          u32x4 w;
          if (mapkind & 4) { w.x = cvt_pk_tb16(v[0], v[1]); w.y = cvt_pk_tb16(v[2], v[3]); w.z = cvt_pk_tb16(v[4], v[5]); w.w = cvt_pk_tb16(v[6], v[7]); }
          else { w.x = cvt_pk_bf16(v[0], v[1]); w.y = cvt_pk_bf16(v[2], v[3]); w.z = cvt_pk_bf16(v[4], v[5]); w.w = cvt_pk_bf16(v[6], v[7]); }
          *(u32x4*)(dst + (size_t)drow * dstld + k0 + c8) = w; }
    }
}

__device__ __forceinline__ void phase_prep(int wv, const Params& p, LAS unsigned char* lds) {
    LAS float* tile = (LAS float*)lds;
    LAS float* ctab = (LAS float*)(lds + 32768);
    const Lane L = get_lane(wv); const int tid = L.tid;
    if (tid < 64) ctab[tid] = cospif((float)tid * (1.0f / 32.0f));
    __syncthreads();
    const size_t gtid = (size_t)L.bid * NTHREADS + tid, gsz = (size_t)gridDim.x * NTHREADS;
    for (int l = 0; l < 2; ++l) {
        unsigned char* wl = p.ws + WS_W + (size_t)l * W_LAYER;
        for (int f = 0; f < 2; ++f) {
            transpose_job(L, tile, p.in[4] + (size_t)(l * 2 + f) * D * DFF, DFF, D, DFF, (bf16_t*)(wl + W_UP) + (size_t)f * 5632 * 1024, 1024, 1, 0);
            transpose_job(L, tile, p.in[5] + (size_t)(l * 2 + f) * D * DFF, DFF, D, DFF, (bf16_t*)(wl + W_UP) + (size_t)f * 5632 * 1024, 1024, 1, 128);
            transpose_job(L, tile, p.in[6] + (size_t)(l * 2 + f) * DFF * D, D, DFF, D, (bf16_t*)(wl + W_DN) + (size_t)f * 1024 * DFF, DFF, 4, 0);
        }
        const float* win = p.in[7] + (size_t)l * D * 1792;
        transpose_job(L, tile, win, 1792, D, 768, (bf16_t*)(wl + W_IN), 1024, 0, 0);
        transpose_job(L, tile, win + 1024, 1792, D, 512, (bf16_t*)(wl + W_IN), 1024, 0, 768);
        for (int i = 0; i < 4; ++i) {
            transpose_job(L, tile, p.in[15] + (size_t)(l * 4 + i) * D * D, D, D, D, (bf16_t*)(wl + W_G), 1024, 0, i * 1024);
            transpose_job(L, tile, p.in[17] + (size_t)(l * 4 + i) * 256 * D, D, 256, D, (bf16_t*)(wl + W_B) + (size_t)i * 1024 * 256, 256, 0, 0);
        }
        transpose_job(L, tile, p.in[18] + (size_t)l * D * D, D, D, D, (bf16_t*)(wl + W_O), 1024, 4, 0);
        { const float* pw = p.in[13] + (size_t)l * 4 * 64 * 64; const float* psc = p.in[14] + (size_t)l * 256; bf16_t* dst = (bf16_t*)(wl + W_IN);
          for (size_t idx = gtid; idx < 256 * 1024; idx += gsz) { const int n = (int)(idx & 255), d = (int)(idx >> 8), g = n >> 6, e = n & 63; float s = 0.f;
              const float* wr_ = win + (size_t)d * 1792 + 1536 + g * 64; const float* pg = pw + (size_t)g * 4096 + e;
#pragma unroll 16
              for (int c = 0; c < 64; ++c) s += wr_[c] * pg[c * 64];
              dst[(size_t)(1280 + n) * 1024 + d] = f2bf(s * psc[n]); } }
        { bf16_t* dst = (bf16_t*)(wl + W_F);
          for (size_t idx = gtid; idx < 512 * 1024; idx += gsz) { const int n = (int)(idx & 511), d = (int)(idx >> 9), part = n >> 8, hh = (n >> 6) & 3, mm = n & 63; float s = 0.f;
              const float* wr_ = win + (size_t)d * 1792 + 768 + hh * 64; const int sh = part ? 16 : 0;
#pragma unroll 16
              for (int c = 0; c < 64; ++c) s += wr_[c] * ctab[((mm * c) - sh) & 63];
              dst[(size_t)n * 1024 + d] = f2bf(s); } }
    }
    { bf16_t* d4 = (bf16_t*)(p.ws + WS_DFT4);
      for (size_t idx = gtid; idx < (size_t)4096 * 512; idx += gsz) { const int k = (int)(idx >> 9), c8 = (int)(idx & 511) * 8; float v[8];
#pragma unroll
          for (int e = 0; e < 8; ++e) { const int col = c8 + e, sp = col & 2047, j = (k * sp) & 4095; const float x = (float)j * (1.0f / 2048.0f); v[e] = (col >> 11) ? -sinpif(x) : cospif(x); }
          u32x4 w; w.x = cvt_pk_tb16(v[0], v[1]); w.y = cvt_pk_tb16(v[2], v[3]); w.z = cvt_pk_tb16(v[4], v[5]); w.w = cvt_pk_tb16(v[6], v[7]);
          *(u32x4*)(d4 + (size_t)k * 4096 + c8) = w; }
      bf16_t* d2 = (bf16_t*)(p.ws + WS_DFT2);
      for (size_t idx = gtid; idx < (size_t)2048 * 256; idx += gsz) { const int k = (int)(idx >> 8), c8 = (int)(idx & 255) * 8; float v[8];
#pragma unroll
          for (int e = 0; e < 8; ++e) { const int col = c8 + e, sp = col & 1023, j = (k * sp) & 2047; const float x = (float)j * (1.0f / 1024.0f); v[e] = (col >> 10) ? -sinpif(x) : cospif(x); }
          u32x4 w; w.x = cvt_pk_tb16(v[0], v[1]); w.y = cvt_pk_tb16(v[2], v[3]); w.z = cvt_pk_tb16(v[4], v[5]); w.w = cvt_pk_tb16(v[6], v[7]);
          *(u32x4*)(d2 + (size_t)k * 2048 + c8) = w; } }
    { const f32x4* xp = (const f32x4*)p.in[0]; const f32x4* xs = (const f32x4*)p.in[1]; u32x2* xb = (u32x2*)(p.ws + WS_XB);
      const size_t nitem = (size_t)T * 256;
      for (size_t base = gtid; base < nitem; base += gsz * 8) {
          f32x4 v[8];
#pragma unroll
          for (int u = 0; u < 8; ++u) { const size_t idx = base + (size_t)u * gsz; v[u] = idx < nitem ? (idx < (size_t)TP * 256 ? xp[idx] : xs[idx - (size_t)TP * 256]) : (f32x4){0.f, 0.f, 0.f, 0.f}; }
#pragma unroll
          for (int u = 0; u < 8; ++u) { const size_t idx = base + (size_t)u * gsz; if (idx < nitem) { u32x2 w; w.x = cvt_pk_bf16(v[u][0], v[u][1]); w.y = cvt_pk_bf16(v[u][2], v[u][3]); xb[idx] = w; } } } }
}

__device__ __forceinline__ void phase_ln(int wv, const Params& p, int l, int which) {
    const Lane L = get_lane(wv);
    const float* g = p.in[2] + (size_t)(l * 3 + which) * 1024; const float* b = p.in[3] + (size_t)(l * 3 + which) * 1024;
    f32x4 gv[4], bv[4];
#pragma unroll
    for (int j = 0; j < 4; ++j) { gv[j] = *(const f32x4*)(g + j * 256 + L.lane * 4); bv[j] = *(const f32x4*)(b + j * 256 + L.lane * 4); }
    bf16_t* xb = (bf16_t*)(p.ws + WS_XB);
    for (int row = L.bid * 8 + L.wid; row < T; row += gridDim.x * 8) {
        float* rp = p.out + (size_t)row * 1024 + L.lane * 4; f32x4 v[4]; float s = 0.f;
#pragma unroll
        for (int j = 0; j < 4; ++j) { v[j] = *(const f32x4*)(rp + j * 256); s += (v[j][0] + v[j][1]) + (v[j][2] + v[j][3]); }
        const float mean = wave_sum(s, L.lane) * (1.0f / 1024.0f); float q = 0.f;
#pragma unroll
        for (int j = 0; j < 4; ++j) { const f32x4 d = v[j] - mean; q += (d[0] * d[0] + d[1] * d[1]) + (d[2] * d[2] + d[3] * d[3]); }
        const float rstd = rsqrtf(wave_sum(q, L.lane) * (1.0f / 1024.0f) + LN_EPS);
#pragma unroll
        for (int j = 0; j < 4; ++j) { const f32x4 o = (v[j] - mean) * rstd * gv[j] + bv[j]; *(f32x4*)(rp + j * 256) = o;
            u32x2 w; w.x = cvt_pk_bf16(o[0], o[1]); w.y = cvt_pk_bf16(o[2], o[3]); *(u32x2*)(xb + (size_t)row * 1024 + j * 256 + L.lane * 4) = w; }
    }
}

__device__ __forceinline__ u32x4 pack8_tb(const f32x4& a, const f32x4& b) { u32x4 w; w.x = cvt_pk_tb16(a[0], a[1]); w.y = cvt_pk_tb16(a[2], a[3]); w.z = cvt_pk_tb16(b[0], b[1]); w.w = cvt_pk_tb16(b[2], b[3]); return w; }
__device__ __forceinline__ u32x4 pack8(const f32x4& a, const f32x4& b) { u32x4 w; w.x = cvt_pk_bf16(a[0], a[1]); w.y = cvt_pk_bf16(a[2], a[3]); w.z = cvt_pk_bf16(b[0], b[1]); w.w = cvt_pk_bf16(b[2], b[3]); return w; }

__device__ __forceinline__ void phase_ffn_up(int wv, const Params& p, LAS unsigned char* lds, int l, int f) {
    const Lane L = get_lane(wv);
    const bf16_t* xb = (const bf16_t*)(p.ws + WS_XB); const bf16_t* W = (const bf16_t*)(p.ws + WS_W + (size_t)l * W_LAYER + W_UP) + (size_t)f * 5632 * 1024; bf16_t* H = (bf16_t*)(p.ws + WS_H);
    const int G = gridDim.x, bid = L.bid;
    auto next = [=](int i, GU& u) -> bool { int pm, pn; if (!tile_order(i * G + bid, 320, 22, pm, pn)) return false;
        u.A = (const char*)(xb + (size_t)pm * 256 * 1024); u.B = (const char*)(W + (size_t)pn * 256 * 1024); u.pm = pm; u.pn = pn; return true; };
    auto epi = [=](f32x4 (&acc)[2][2][4][2], const GU& u) {
        const int row0 = u.pm * 256 + L.wr * 64 + L.fr, col0 = u.pn * 128 + L.wc * 32 + 8 * L.fq;
#pragma unroll
        for (int ai = 0; ai < 2; ++ai)
#pragma unroll
            for (int m = 0; m < 4; ++m) { f32x4 o[2];
#pragma unroll
                for (int n = 0; n < 2; ++n)
#pragma unroll
                    for (int j = 0; j < 4; ++j) o[n][j] = silu_f(acc[ai][0][m][n][j]) * acc[ai][1][m][n][j];
                *(u32x4*)(H + (size_t)(row0 + ai * 128 + m * 16) * DFF + col0) = pack8_tb(o[0], o[1]); }
    };
    { f32x4 acc_[2][2][4][2]; gemm_stream<true, false, false>(L, lds, 1024, next, epi, acc_); }
}

__device__ __forceinline__ float lane_xor_add(float v, int lane, int mask) { return v + __int_as_float(__builtin_amdgcn_ds_bpermute((lane ^ mask) << 2, __float_as_int(v))); }
__device__ __forceinline__ void phase_down_ln(int wv, const Params& p, LAS unsigned char* lds, const bf16_t* A, int K, const bf16_t* W, float cscale, int l, int which) {
    typedef float f32x2v __attribute__((ext_vector_type(2)));
    const Lane L = get_lane(wv);
    const int wid = __builtin_amdgcn_readfirstlane(L.tid >> 6), lane = L.lane, wr = L.wr, wc = L.wc, fr = L.fr, fq = L.fq;
    float* out = p.out; bf16_t* xb = (bf16_t*)(p.ws + WS_XB);
    unsigned long long* xch = (unsigned long long*)(p.ws + WS_XCH); unsigned* cnt = (unsigned*)(p.ws + CTL_CNT);
    const float* lg = p.in[2] + (size_t)(l * 3 + which) * 1024; const float* lb = p.in[3] + (size_t)(l * 3 + which) * 1024;
    const unsigned want = 32u * (unsigned)(l * 3 + which + 1);
    LAS f32x2v* P = (LAS f32x2v*)lds; LAS f32x2v* S = (LAS f32x2v*)(lds + 8192);
    const int nround = (1280 + (int)gridDim.x - 1) / (int)gridDim.x;
    for (int it = 0; it < nround; ++it) { int pm, pn;
        if (!tile_order((nround - 1 - it) * gridDim.x + L.bid, 320, 4, pm, pn)) continue;
        f32x4 acc[2][2][4][2];
        { auto next = [=](int k, GU& u) -> bool { if (k > 0) return false; u.A = (const char*)(A + (size_t)pm * 256 * K); u.B = (const char*)(W + (size_t)pn * 256 * K); u.pm = pm; u.pn = pn; return true; };
          auto epi = [=](f32x4 (&)[2][2][4][2], const GU&) {};
          gemm_stream<true, false, true>(L, lds, K, next, epi, acc); }
        int row0 = pm * 256 + wr * 64 + fr; asm volatile("" : "+v"(row0));
        const int col0 = pn * 256 + wc * 32 + 8 * fq;
        {
#pragma unroll
            for (int ai = 0; ai < 2; ++ai) {
                u32x4 xr[4][2];
#pragma unroll
                for (int m = 0; m < 4; ++m)
#pragma unroll
                    for (int bj = 0; bj < 2; ++bj) xr[m][bj] = *(const u32x4*)(xb + (size_t)(row0 + ai * 128 + m * 16) * 1024 + col0 + bj * 128);
#pragma unroll
                for (int m = 0; m < 4; ++m)
#pragma unroll
                    for (int bj = 0; bj < 2; ++bj) { const u32x4 w = xr[m][bj];
                        acc[ai][bj][m][0] = (f32x4){bflo(w.x), bfhi(w.x), bflo(w.y), bfhi(w.y)} * ALPHA + acc[ai][bj][m][0] * cscale;
                        acc[ai][bj][m][1] = (f32x4){bflo(w.z), bfhi(w.z), bflo(w.w), bfhi(w.w)} * ALPHA + acc[ai][bj][m][1] * cscale; }
#pragma unroll
                for (int m = 0; m < 4; ++m) asm volatile("" : "+v"(acc[ai][0][m][0]), "+v"(acc[ai][0][m][1]), "+v"(acc[ai][1][m][0]), "+v"(acc[ai][1][m][1]));
                asm volatile("" ::: "memory"); }
        }
#pragma unroll
        for (int ai = 0; ai < 2; ++ai)
#pragma unroll
            for (int m = 0; m < 4; ++m) { float sm = 0.f;
#pragma unroll
                for (int bj = 0; bj < 2; ++bj)
#pragma unroll
                    for (int n = 0; n < 2; ++n) { const f32x4 x = acc[ai][bj][m][n]; sm += (x[0] + x[1]) + (x[2] + x[3]); }
                sm = lane_xor_add(sm, lane, 16); sm = lane_xor_add(sm, lane, 32);
                const float mw = sm * (1.0f / 64.0f); float q = 0.f;
#pragma unroll
                for (int bj = 0; bj < 2; ++bj)
#pragma unroll
                    for (int n = 0; n < 2; ++n) { const f32x4 d = acc[ai][bj][m][n] - mw; q += (d[0] * d[0] + d[1] * d[1]) + (d[2] * d[2] + d[3] * d[3]); }
                q = lane_xor_add(q, lane, 16); q = lane_xor_add(q, lane, 32);
                if (fq == 0) P[(ai * 128 + wr * 64 + m * 16 + fr) * 4 + wc] = (f32x2v){mw, q}; }
        __syncthreads();
        const int row = wid * 32 + (lane & 31);
        if (lane < 32) { const f32x2v a = P[row * 4 + 0], b = P[row * 4 + 1], c = P[row * 4 + 2], d = P[row * 4 + 3];
            const float mt = (a.x + b.x + c.x + d.x) * 0.25f; const float da = a.x - mt, db = b.x - mt, dc = c.x - mt, dd = d.x - mt;
            const float m2 = (a.y + b.y) + (c.y + d.y) + 64.0f * ((da * da + db * db) + (dc * dc + dd * dd));
            __hip_atomic_store(xch + ((size_t)(pm * 256 + row) * 4 + pn), ((unsigned long long)__float_as_uint(m2) << 32) | __float_as_uint(mt), __ATOMIC_RELAXED, __HIP_MEMORY_SCOPE_AGENT); }
        asm volatile("s_waitcnt vmcnt(0)" ::: "memory");
        if (lane == 0) __hip_atomic_fetch_add(cnt + 64 * pm, 1u, __ATOMIC_RELAXED, __HIP_MEMORY_SCOPE_AGENT);
        if (wid == 0) {
            for (unsigned polls = 0; polls < (1u << 21); ++polls) {
                if ((unsigned)__builtin_amdgcn_readfirstlane(__hip_atomic_load(cnt + 64 * pm, __ATOMIC_RELAXED, __HIP_MEMORY_SCOPE_AGENT)) >= want) break;
                __builtin_amdgcn_s_sleep(1); }
            __builtin_amdgcn_fence(__ATOMIC_ACQUIRE, "agent"); }
        __syncthreads();
        if (lane < 32) { const unsigned long long* slot = xch + (size_t)(pm * 256 + row) * 4; float mt[4], m2[4], ms = 0.f;
#pragma unroll
            for (int t = 0; t < 4; ++t) { const unsigned long long w = __hip_atomic_load(slot + t, __ATOMIC_RELAXED, __HIP_MEMORY_SCOPE_AGENT); mt[t] = __uint_as_float((unsigned)w); m2[t] = __uint_as_float((unsigned)(w >> 32)); ms += mt[t]; }
            const float mean = ms * 0.25f; float q = 0.f;
#pragma unroll
            for (int t = 0; t < 4; ++t) { const float dm = mt[t] - mean; q += m2[t] + 256.0f * dm * dm; }
            S[row] = (f32x2v){mean, rsqrtf(q * (1.0f / 1024.0f) + LN_EPS)}; }
        __syncthreads();
        int col0o = col0; asm volatile("" : "+v"(col0o));
        const bool fin = (l == 1 && which == 2);
#pragma unroll
        for (int bj = 0; bj < 2; ++bj) {
            const f32x4 g0 = *(const f32x4*)(lg + col0o + bj * 128), g1 = *(const f32x4*)(lg + col0o + bj * 128 + 4), b0 = *(const f32x4*)(lb + col0o + bj * 128), b1 = *(const f32x4*)(lb + col0o + bj * 128 + 4);
#pragma unroll
            for (int ai = 0; ai < 2; ++ai)
#pragma unroll
                for (int m = 0; m < 4; ++m) { const int r = ai * 128 + wr * 64 + m * 16 + fr; const f32x2v sr = S[r]; const size_t off = (size_t)(pm * 256 + r) * 1024 + col0o + bj * 128;
                    const f32x4 o0 = (acc[ai][bj][m][0] - sr.x) * sr.y * g0 + b0, o1 = (acc[ai][bj][m][1] - sr.x) * sr.y * g1 + b1;
                    *(u32x4*)(xb + off) = pack8(o0, o1);
                    if (fin) { *(f32x4*)(out + off) = o0; *(f32x4*)(out + off + 4) = o1; } }
            asm volatile("" ::: "memory"); }
        __syncthreads();
    }
}

__device__ __forceinline__ void phase_mix_in(int wv, const Params& p, LAS unsigned char* lds, int l) {
    const Lane L = get_lane(wv);
    const bf16_t* xb = (const bf16_t*)(p.ws + WS_XB); const unsigned char* wl = p.ws + WS_W + (size_t)l * W_LAYER;
    const bf16_t* Win = (const bf16_t*)(wl + W_IN); const bf16_t* Wf = (const bf16_t*)(wl + W_F);
    bf16_t* Z = (bf16_t*)(p.ws + WS_Z); bf16_t* ZT = (bf16_t*)(p.ws + WS_ZT);
    const int G = gridDim.x, bid = L.bid;
    auto next = [=](int i, GU& u) -> bool { const int k = i * G + bid; int pm, pn;
        if (k < 1920) { tile_order(k, 320, 6, pm, pn); u.A = (const char*)(xb + (size_t)pm * 256 * 1024); u.B = (const char*)(Win + (size_t)pn * 256 * 1024); u.aux = 0; }
        else if (k < 2560) { tile_order(k - 1920, 320, 2, pm, pn); u.A = (const char*)(Wf + (size_t)pn * 256 * 1024); u.B = (const char*)(xb + (size_t)pm * 256 * 1024); u.aux = 1; }
        else return false;
        u.pm = pm; u.pn = pn; return true; };
    auto epi = [=](f32x4 (&acc)[2][2][4][2], const GU& u) {
        if (u.aux == 0) {
            const int row0 = u.pm * 256 + L.wr * 64 + L.fr, col0 = u.pn * 256 + L.wc * 32 + 8 * L.fq; const bool act = (u.pn == 3 || u.pn == 4);
#pragma unroll
            for (int ai = 0; ai < 2; ++ai)
#pragma unroll
                for (int m = 0; m < 4; ++m)
#pragma unroll
                    for (int bj = 0; bj < 2; ++bj) { f32x4 o0 = acc[ai][bj][m][0], o1 = acc[ai][bj][m][1];
                        if (act) {
#pragma unroll
                            for (int j = 0; j < 4; ++j) { o0[j] = gelu_tanh(o0[j]); o1[j] = gelu_tanh(o1[j]); } }
                        *(u32x4*)(Z + (size_t)(row0 + ai * 128 + m * 16) * 1536 + col0 + bj * 128) = pack8(o0, o1); }
        } else {
            const int tok0 = u.pm * 256, part = u.pn;
            size_t base; int S;
            if (tok0 < TP) { S = 4096; base = (size_t)(tok0 >> 12) * 256 * 2 * 4096 + (tok0 & 4095); }
            else { S = 2048; const int t2 = tok0 - TP; base = (size_t)TP * 512 + (size_t)(t2 >> 11) * 256 * 2 * 2048 + (t2 & 2047); }
#pragma unroll
            for (int ai = 0; ai < 2; ++ai)
#pragma unroll
                for (int m = 0; m < 4; ++m) { const int colc = ai * 128 + L.wr * 64 + m * 16 + L.fr;
#pragma unroll
                    for (int bj = 0; bj < 2; ++bj)
                        *(u32x4*)(ZT + base + (size_t)(colc * 2 + part) * S + bj * 128 + L.wc * 32 + 8 * L.fq) = pack8_tb(acc[ai][bj][m][0], acc[ai][bj][m][1]); }
        }
    };
    { f32x4 acc_[2][2][4][2]; gemm_stream<true, false, false>(L, lds, 1024, next, epi, acc_); }
}

__device__ __forceinline__ void phase_fold(int wv, const Params& p) {
    const Lane L = get_lane(wv);
    const bf16_t* ZT = (const bf16_t*)(p.ws + WS_ZT); bf16_t* ZF = (bf16_t*)(p.ws + WS_SCR);
    const size_t gtid = (size_t)L.bid * NTHREADS + L.tid, gsz = (size_t)gridDim.x * NTHREADS;
    for (size_t idx = gtid; idx < (size_t)4096 * 512 + (size_t)2048 * 256; idx += gsz) {
        int S, row, part, o; const bf16_t* zrow; bf16_t* frow;
        if (idx < (size_t)4096 * 512) { S = 4096; row = (int)(idx >> 9); part = (int)(idx >> 8) & 1; o = (int)(idx & 255) * 8; zrow = ZT + ((size_t)row * 2 + part) * 4096; frow = ZF + (size_t)row * 4096 + part * 2048; }
        else { const size_t i2 = idx - (size_t)4096 * 512; S = 2048; row = (int)(i2 >> 8); part = (int)(i2 >> 7) & 1; o = (int)(i2 & 127) * 8;
               zrow = ZT + (size_t)TP * 512 + ((size_t)row * 2 + part) * 2048; frow = ZF + (size_t)TP * 256 + (size_t)row * 2048 + part * 1024; }
        const u32x4 a = *(const u32x4*)(zrow + o);
        const u32x4 v1 = *(const u32x4*)(zrow + S - o - 8);
        const unsigned v2 = o > 0 ? *(const unsigned*)(zrow + S - o) : 0u;
        float z[8], mz[8];
        z[0] = tblo(a.x); z[1] = tbhi(a.x); z[2] = tblo(a.y); z[3] = tbhi(a.y); z[4] = tblo(a.z); z[5] = tbhi(a.z); z[6] = tblo(a.w); z[7] = tbhi(a.w);
        mz[0] = tblo(v2); mz[1] = tbhi(v1.w); mz[2] = tblo(v1.w); mz[3] = tbhi(v1.z); mz[4] = tblo(v1.z); mz[5] = tbhi(v1.y); mz[6] = tblo(v1.y); mz[7] = tbhi(v1.x);
        float r[8];
#pragma unroll
        for (int j = 0; j < 8; ++j) r[j] = part ? z[j] - mz[j] : z[j] + mz[j];
        if (part && o == 0) r[0] = 0.f;
        u32x4 w; w.x = cvt_pk_tb16(r[0], r[1]); w.y = cvt_pk_tb16(r[2], r[3]); w.z = cvt_pk_tb16(r[4], r[5]); w.w = cvt_pk_tb16(r[6], r[7]);
        *(u32x4*)(frow + o) = w;
    }
}

__device__ __forceinline__ void phase_dft(int wv, const Params& p, LAS unsigned char* lds) {
    const Lane L = get_lane(wv);
    const bf16_t* ZT = (const bf16_t*)(p.ws + WS_ZT); const bf16_t* ZF = (const bf16_t*)(p.ws + WS_SCR); bf16_t* BR1 = (bf16_t*)(p.ws + WS_BR) + (size_t)1 * T * 256;
    const bf16_t* D4 = (const bf16_t*)(p.ws + WS_DFT4); const bf16_t* D2 = (const bf16_t*)(p.ws + WS_DFT2);
    const int G = gridDim.x, bid = L.bid;
    {
        auto next = [=](int i, GU& u) -> bool { const int v = i * G + bid; if (v >= 256) return false; const int b = v >> 4, pm = v & 15;
            u.A = (const char*)(D4 + (size_t)pm * 256 * 4096); u.B = (const char*)(ZF + (size_t)b * 256 * 4096); u.pm = b * 4096 + pm * 256; u.pn = b; return true; };
        auto epi = [=](f32x4 (&acc)[2][2][4][2], const GU& u) {
            const int row0 = u.pm + L.wr * 64 + L.fr, col0 = L.wc * 32 + 8 * L.fq; const float scale = 1.0f / 512.0f, sg = (L.fr & 1) ? -scale : scale;
#pragma unroll
            for (int bj = 0; bj < 2; ++bj) { f32x4 h0, h1;
#pragma unroll
                for (int j = 0; j < 4; ++j) { h0[j] = sg * tblo((unsigned)ZT[((size_t)(u.pn * 256 + col0 + bj * 128 + j) * 2) * 4096 + 2048]); h1[j] = sg * tblo((unsigned)ZT[((size_t)(u.pn * 256 + col0 + bj * 128 + 4 + j) * 2) * 4096 + 2048]); }
#pragma unroll
                for (int ai = 0; ai < 2; ++ai)
#pragma unroll
                    for (int m = 0; m < 4; ++m)
                        *(u32x4*)(BR1 + (size_t)(row0 + ai * 128 + m * 16) * 256 + col0 + bj * 128) = pack8(acc[ai][bj][m][0] * scale + h0, acc[ai][bj][m][1] * scale + h1); }
        };
        { f32x4 acc_[2][2][4][2]; gemm_stream<true, false, true>(L, lds, 4096, next, epi, acc_); }
    }
    {
        auto next = [=](int i, GU& u) -> bool { const int v = i * G + (G - 1 - bid); if (v >= 64) return false; const int b = v >> 3, pm = v & 7;
            u.A = (const char*)(D2 + (size_t)pm * 256 * 2048); u.B = (const char*)(ZF + (size_t)TP * 256 + (size_t)b * 256 * 2048); u.pm = TP + b * 2048 + pm * 256; u.pn = b; return true; };
        auto epi = [=](f32x4 (&acc)[2][2][4][2], const GU& u) {
            const int row0 = u.pm + L.wr * 64 + L.fr, col0 = L.wc * 32 + 8 * L.fq; const float scale = 0.00276213586400995f, sg = (L.fr & 1) ? -scale : scale;
#pragma unroll
            for (int bj = 0; bj < 2; ++bj) { f32x4 h0, h1;
#pragma unroll
                for (int j = 0; j < 4; ++j) { h0[j] = sg * tblo((unsigned)ZT[(size_t)TP * 512 + ((size_t)(u.pn * 256 + col0 + bj * 128 + j) * 2) * 2048 + 1024]); h1[j] = sg * tblo((unsigned)ZT[(size_t)TP * 512 + ((size_t)(u.pn * 256 + col0 + bj * 128 + 4 + j) * 2) * 2048 + 1024]); }
#pragma unroll
                for (int ai = 0; ai < 2; ++ai)
#pragma unroll
                    for (int m = 0; m < 4; ++m)
                        *(u32x4*)(BR1 + (size_t)(row0 + ai * 128 + m * 16) * 256 + col0 + bj * 128) = pack8(acc[ai][bj][m][0] * scale + h0, acc[ai][bj][m][1] * scale + h1); }
        };
        { f32x4 acc_[2][2][4][2]; gemm_stream<true, false, true>(L, lds, 2048, next, epi, acc_); }
    }
}

__device__ __forceinline__ void phase_mixers(int wv, const Params& p, LAS unsigned char* lds, int l) {
    const Lane L = get_lane(wv); const int tid = L.tid;
    const bf16_t* Z = (const bf16_t*)(p.ws + WS_Z);
    bf16_t* BR0 = (bf16_t*)(p.ws + WS_BR); bf16_t* BR2 = BR0 + (size_t)2 * T * 256; bf16_t* BR3 = BR0 + (size_t)3 * T * 256;
    const size_t gtid = (size_t)L.bid * NTHREADS + tid, gsz = (size_t)gridDim.x * NTHREADS;
    const float* cw = p.in[8] + (size_t)l * 3 * 256;
    for (size_t idx = gtid; idx < (size_t)T * 32; idx += gsz) {
        const int t = (int)(idx >> 5), c8 = (int)(idx & 31) * 8; int s, S; if (t < TP) { s = t & 4095; S = 4096; } else { s = (t - TP) & 2047; S = 2048; }
        const bf16_t* zr = Z + (size_t)t * 1536 + c8;
        { const u32x4 hv = *(const u32x4*)zr, gb = *(const u32x4*)(zr + 256), gc = *(const u32x4*)(zr + 512);
          u32x4 hp = (u32x4){0u, 0u, 0u, 0u}, cp = hp, hn = hp, cn = hp;
          if (s > 0) { hp = *(const u32x4*)(zr - 1536); cp = *(const u32x4*)(zr - 1536 + 512); }
          if (s + 1 < S) { hn = *(const u32x4*)(zr + 1536); cn = *(const u32x4*)(zr + 1536 + 512); }
          const f32x4 w0a = *(const f32x4*)(cw + c8), w0b = *(const f32x4*)(cw + c8 + 4), w1a = *(const f32x4*)(cw + 256 + c8), w1b = *(const f32x4*)(cw + 256 + c8 + 4), w2a = *(const f32x4*)(cw + 512 + c8), w2b = *(const f32x4*)(cw + 512 + c8 + 4);
          float o[8];
#pragma unroll
          for (int e = 0; e < 4; ++e) {
              const float k0l = e < 2 ? w0a[2 * e] : w0b[2 * e - 4], k0h = e < 2 ? w0a[2 * e + 1] : w0b[2 * e - 3];
              const float k1l = e < 2 ? w1a[2 * e] : w1b[2 * e - 4], k1h = e < 2 ? w1a[2 * e + 1] : w1b[2 * e - 3];
              const float k2l = e < 2 ? w2a[2 * e] : w2b[2 * e - 4], k2h = e < 2 ? w2a[2 * e + 1] : w2b[2 * e - 3];
              o[2 * e] = bflo(gb[e]) * (k0l * bflo(cp[e]) * bflo(hp[e]) + k1l * bflo(gc[e]) * bflo(hv[e]) + k2l * bflo(cn[e]) * bflo(hn[e]));
              o[2 * e + 1] = bfhi(gb[e]) * (k0h * bfhi(cp[e]) * bfhi(hp[e]) + k1h * bfhi(gc[e]) * bfhi(hv[e]) + k2h * bfhi(cn[e]) * bfhi(hn[e])); }
          u32x4 w; w.x = cvt_pk_bf16(o[0], o[1]); w.y = cvt_pk_bf16(o[2], o[3]); w.z = cvt_pk_bf16(o[4], o[5]); w.w = cvt_pk_bf16(o[6], o[7]);
          *(u32x4*)(BR0 + (size_t)t * 256 + c8) = w; }
        { const int half = 1 << (c8 >> 6); const int lo = s - half < 0 ? 0 : s - half, hi = s + half > S ? S : s + half;
          u32x4 pv[16];
#pragma unroll
          for (int jj = 0; jj < 16; ++jj) { const int j = s - half + jj; const bool ok = jj < 2 * half && j >= 0 && j < S;
              pv[jj] = ok ? *(const u32x4*)(zr + 1280 + (ptrdiff_t)(j - s) * 1536) : (u32x4){0u, 0u, 0u, 0u}; }
          float sum[8];
#pragma unroll
          for (int e = 0; e < 8; ++e) sum[e] = 0.f;
#pragma unroll
          for (int jj = 0; jj < 16; ++jj) {
#pragma unroll
              for (int e = 0; e < 4; ++e) { sum[2 * e] += bflo(pv[jj][e]); sum[2 * e + 1] += bfhi(pv[jj][e]); } }
          const float inv = 1.0f / (float)(hi - lo); const u32x4 zc = *(const u32x4*)(zr + 1280);
          u32x4 w;
#pragma unroll
          for (int e = 0; e < 4; ++e) w[e] = cvt_pk_bf16(sum[2 * e] * inv - bflo(zc[e]), sum[2 * e + 1] * inv - bfhi(zc[e]));
          *(u32x4*)(BR3 + (size_t)t * 256 + c8) = w; }
    }
    LAS bf16_t* VT = (LAS bf16_t*)lds;
    LAS float* red = (LAS float*)(lds + 69632);
    const float* lg = p.in[9] + (size_t)l * 256; const float* lb = p.in[10] + (size_t)l * 256;
    const float* sw = p.in[11] + (size_t)l * 4 * 128 * 128; const float* sb = p.in[12] + (size_t)l * 4 * 128;
    for (int ch = L.bid; ch < T / 128; ch += gridDim.x) {
        const int t0 = ch * 128, q = tid & 127, part = tid >> 7;
        const bf16_t* vp = Z + (size_t)(t0 + q) * 1536 + 1024 + part * 64;
        __syncthreads();
        float s = 0.f, ss = 0.f;
#pragma unroll
        for (int j = 0; j < 8; ++j) { const u32x4 w = *(const u32x4*)(vp + j * 8);
#pragma unroll
            for (int e = 0; e < 4; ++e) { const float a = bflo(w[e]), b = bfhi(w[e]); s += a + b; ss += a * a + b * b; } }
        red[(part * 128 + q) * 2] = s; red[(part * 128 + q) * 2 + 1] = ss;
        __syncthreads();
        float S1 = 0.f, S2 = 0.f;
#pragma unroll
        for (int pp = 0; pp < 4; ++pp) { S1 += red[(pp * 128 + q) * 2]; S2 += red[(pp * 128 + q) * 2 + 1]; }
        const float mean = S1 * (1.0f / 256.0f), var = S2 * (1.0f / 256.0f) - mean * mean, rstd = rsqrtf((var > 0.f ? var : 0.f) + LN_EPS);
#pragma unroll
        for (int j = 0; j < 8; ++j) { const u32x4 w = *(const u32x4*)(vp + j * 8); const int c0 = part * 64 + j * 8;
#pragma unroll
            for (int e = 0; e < 4; ++e) { const float a = (bflo(w[e]) - mean) * rstd * lg[c0 + 2 * e] + lb[c0 + 2 * e], b = (bfhi(w[e]) - mean) * rstd * lg[c0 + 2 * e + 1] + lb[c0 + 2 * e + 1];
                VT[(c0 + 2 * e) * 136 + q] = f2bf(a); VT[(c0 + 2 * e + 1) * 136 + q] = f2bf(b); } }
        __syncthreads();
        const int hh = L.wid >> 1, ph = L.wid & 1;
        f32x4 a2[4][4];
#pragma unroll
        for (int ct = 0; ct < 4; ++ct)
#pragma unroll
            for (int pt = 0; pt < 4; ++pt) a2[ct][pt] = (f32x4){0.f, 0.f, 0.f, 0.f};
#pragma unroll
        for (int ks = 0; ks < 4; ++ks) {
            bf16x8 wf[4];
#pragma unroll
            for (int pt = 0; pt < 4; ++pt) { const float* wp = sw + ((size_t)(hh * 128 + ph * 64 + pt * 16 + L.fr) * 128 + ks * 32 + L.fq * 8);
                const f32x4 w0 = *(const f32x4*)wp, w1 = *(const f32x4*)(wp + 4); wf[pt] = __builtin_bit_cast(bf16x8, pack8(w0, w1)); }
#pragma unroll
            for (int ct = 0; ct < 4; ++ct) { const bf16x8 vf = *(const LAS bf16x8*)(VT + (hh * 64 + ct * 16 + L.fr) * 136 + ks * 32 + L.fq * 8);
#pragma unroll
                for (int pt = 0; pt < 4; ++pt) a2[ct][pt] = __builtin_amdgcn_mfma_f32_16x16x32_f16(__builtin_bit_cast(h16x8_t, vf), __builtin_bit_cast(h16x8_t, wf[pt]), a2[ct][pt], 0, 0, 0); }
        }
#pragma unroll
        for (int pt = 0; pt < 4; ++pt) { const int pp = ph * 64 + pt * 16 + L.fr, t = t0 + pp; const float bias = sb[hh * 128 + pp];
#pragma unroll
            for (int ct = 0; ct < 4; ++ct) { const int c = hh * 64 + ct * 16 + 4 * L.fq; const u32x2 u = *(const u32x2*)(Z + (size_t)t * 1536 + 768 + c);
                u32x2 w; w.x = cvt_pk_bf16(bflo(u.x) * (a2[ct][pt][0] + bias), bfhi(u.x) * (a2[ct][pt][1] + bias)); w.y = cvt_pk_bf16(bflo(u.y) * (a2[ct][pt][2] + bias), bfhi(u.y) * (a2[ct][pt][3] + bias));
                *(u32x2*)(BR2 + (size_t)t * 256 + c) = w; } }
    }
}

__device__ __forceinline__ void phase_gate_branch(int wv, const Params& p, LAS unsigned char* lds, int l) {
    const Lane L = get_lane(wv);
    const bf16_t* xb = (const bf16_t*)(p.ws + WS_XB); const unsigned char* wl = p.ws + WS_W + (size_t)l * W_LAYER;
    const bf16_t* Wg = (const bf16_t*)(wl + W_G); const bf16_t* Wb = (const bf16_t*)(wl + W_B); const bf16_t* BR = (const bf16_t*)(p.ws + WS_BR);
    const float* bg = p.in[16] + (size_t)l * 4 * 1024; bf16_t* MRG = (bf16_t*)(p.ws + WS_MRG);
    unsigned char* scr = p.ws + WS_SCR + (size_t)L.bid * 393216;
    const int G = gridDim.x, bid = L.bid;
    auto next = [=](int k, GU& u) -> bool { int pm, pn; if (!tile_order((k >> 3) * G + bid, 320, 4, pm, pn)) return false;
        const int sub = k & 7, i = sub >> 1; u.pm = pm; u.pn = pn; u.aux = sub;
        if (!(sub & 1)) { u.A = (const char*)(xb + (size_t)pm * 256 * 1024); u.B = (const char*)(Wg + (size_t)(i * 1024 + pn * 256) * 1024); u.K = 1024; }
        else { u.A = (const char*)(BR + ((size_t)i * T + (size_t)pm * 256) * 256); u.B = (const char*)(Wb + ((size_t)i * 1024 + pn * 256) * 256); u.K = 256; }
        return true; };
    auto epi = [=](f32x4 (&acc)[2][2][4][2], const GU& u) {
        unsigned loff = (unsigned)L.tid * 16u; asm volatile("" : "+v"(loff));
        const int i = u.aux >> 1; const int col0 = u.pn * 256 + L.wc * 32 + 8 * L.fq;
        if (!(u.aux & 1)) {
#pragma unroll
            for (int bj = 0; bj < 2; ++bj) { const f32x4 b0 = *(const f32x4*)(bg + i * 1024 + col0 + bj * 128), b1 = *(const f32x4*)(bg + i * 1024 + col0 + bj * 128 + 4);
#pragma unroll
                for (int ai = 0; ai < 2; ++ai)
#pragma unroll
                    for (int m = 0; m < 4; ++m) { f32x4 g0 = acc[ai][bj][m][0] + b0, g1 = acc[ai][bj][m][1] + b1;
#pragma unroll
                        for (int j = 0; j < 4; ++j) { g0[j] = sigmoid_f(g0[j]); g1[j] = sigmoid_f(g1[j]); }
                        *(u32x4*)(scr + (loff + (unsigned)((ai * 8 + bj * 4 + m) * 8192))) = pack8(g0, g1); asm volatile("" ::: "memory"); __builtin_amdgcn_sched_barrier(0); } }
        } else {
            int row0o = u.pm * 256 + L.wr * 64 + L.fr; asm volatile("" : "+v"(row0o));
            asm volatile("s_waitcnt vmcnt(0)" ::: "memory");
#pragma unroll
            for (int ai = 0; ai < 2; ++ai) {
                u32x4 g[8], q[8];
#pragma unroll
                for (int s8 = 0; s8 < 8; ++s8) { g[s8] = *(const u32x4*)(scr + (loff + (unsigned)((ai * 8 + s8) * 8192)));
                    if (i > 0) q[s8] = *(const u32x4*)(scr + (loff + (unsigned)(131072 + (ai * 8 + s8) * 8192))); else q[s8] = (u32x4){0u, 0u, 0u, 0u}; }
#pragma unroll
                for (int bj = 0; bj < 2; ++bj)
#pragma unroll
                    for (int m = 0; m < 4; ++m) { const int s8 = bj * 4 + m;
                        const f32x4 v0 = acc[ai][bj][m][0] * (f32x4){bflo(g[s8].x), bfhi(g[s8].x), bflo(g[s8].y), bfhi(g[s8].y)} + (f32x4){bflo(q[s8].x), bfhi(q[s8].x), bflo(q[s8].y), bfhi(q[s8].y)};
                        const f32x4 v1 = acc[ai][bj][m][1] * (f32x4){bflo(g[s8].z), bfhi(g[s8].z), bflo(g[s8].w), bfhi(g[s8].w)} + (f32x4){bflo(q[s8].z), bfhi(q[s8].z), bflo(q[s8].w), bfhi(q[s8].w)};
                        if (i < 3) *(u32x4*)(scr + (loff + (unsigned)(131072 + (ai * 8 + s8) * 8192))) = pack8(v0, v1);
                        else *(u32x4*)(MRG + (size_t)(row0o + ai * 128 + m * 16) * 1024 + col0 + bj * 128) = pack8_tb(v0, v1); }
                asm volatile("" ::: "memory"); __builtin_amdgcn_sched_barrier(0);
            }
        }
    };
    { f32x4 acc_[2][2][4][2]; gemm_stream<true, true, false>(L, lds, 1024, next, epi, acc_); }
}

__device__ __forceinline__ void grid_barrier(int wv, unsigned* ctr, unsigned target) {
    __syncthreads();
    if (wv == 0 && lane_id() == 0) {
        __builtin_amdgcn_fence(__ATOMIC_RELEASE, "agent");
        __hip_atomic_fetch_add(ctr, 1u, __ATOMIC_RELAXED, __HIP_MEMORY_SCOPE_AGENT);
        while (__hip_atomic_load(ctr, __ATOMIC_RELAXED, __HIP_MEMORY_SCOPE_AGENT) < target) __builtin_amdgcn_s_sleep(1);
        __builtin_amdgcn_fence(__ATOMIC_ACQUIRE, "agent");
    }
    __syncthreads();
}

__global__ void __launch_bounds__(NTHREADS, 2) fwd_kernel(Params p) {
    extern __shared__ __attribute__((aligned(16))) unsigned char lds_raw[];
    LAS unsigned char* lds = (LAS unsigned char*)lds_raw;
    cg::grid_group grid = cg::this_grid();
    unsigned* bar = (unsigned*)p.ws;
    const int wv = __builtin_amdgcn_readfirstlane((int)threadIdx.x >> 6);
    if (blockIdx.x == 0) { const int t0 = wv * 64 + lane_id(); if (t0 == 0) __hip_atomic_store(bar, 0u, __ATOMIC_RELAXED, __HIP_MEMORY_SCOPE_AGENT);
        for (int i = t0; i < 320; i += NTHREADS) __hip_atomic_store((unsigned*)(p.ws + CTL_CNT) + 64 * i, 0u, __ATOMIC_RELAXED, __HIP_MEMORY_SCOPE_AGENT); }
    for (int ph = p.ph_lo; ph < p.ph_hi; ++ph) {
        if (ph == p.ph_lo + 1) grid.sync();
        else if (ph > p.ph_lo + 1) grid_barrier(wv, bar, (unsigned)(ph - p.ph_lo - 1) * gridDim.x);
        if (ph == 0) { phase_prep(wv, p, lds); continue; }
        const int l = (ph - 1) / 9, s = (ph - 1) % 9;
        const unsigned char* wl = p.ws + WS_W + (size_t)l * W_LAYER;
        if (s == 0 || s == 7) phase_ffn_up(wv, p, lds, l, s == 0 ? 0 : 1);
        else if (s == 1 || s == 8) phase_down_ln(wv, p, lds, (const bf16_t*)(p.ws + WS_H), DFF, (const bf16_t*)(wl + W_DN) + (size_t)(s == 1 ? 0 : 1) * 1024 * DFF, 0.5f, l, s == 1 ? 0 : 2);
        else if (s == 2) phase_mix_in(wv, p, lds, l);
        else if (s == 3) { phase_fold(wv, p); phase_mixers(wv, p, lds, l); }
        else if (s == 4) phase_dft(wv, p, lds);
        else if (s == 5) phase_gate_branch(wv, p, lds, l);
        else if (s == 6) phase_down_ln(wv, p, lds, (const bf16_t*)(p.ws + WS_MRG), 1024, (const bf16_t*)(wl + W_O), 1.0f, l, 1);
        __syncthreads();
    }
}

extern "C" void kernel_launch(void* const* d_in, const int* in_sizes, int n_in, void* d_out, int out_size, void* d_ws, size_t ws_size, hipStream_t stream) {
    static int grid = 0;
    if (grid == 0) {
        if (n_in != 19 || out_size != T * D || ws_size < WS_END) { fprintf(stderr, "kernel_launch: unexpected shapes (n_in %d, out %d, ws %zu)\n", n_in, out_size, ws_size); grid = -1; return; }
        int dev = 0, cus = 0, per_cu = 0;
        hipGetDevice(&dev); hipDeviceGetAttribute(&cus, hipDeviceAttributeMultiprocessorCount, dev);
        if (hipFuncSetAttribute((const void*)fwd_kernel, hipFuncAttributeMaxDynamicSharedMemorySize, LDS_BYTES) != hipSuccess) { fprintf(stderr, "kernel_launch: hipFuncSetAttribute failed\n"); grid = -1; return; }
        if (hipOccupancyMaxActiveBlocksPerMultiprocessor(&per_cu, (const void*)fwd_kernel, NTHREADS, LDS_BYTES) != hipSuccess || per_cu < 1) { fprintf(stderr, "kernel_launch: occupancy query says %d\n", per_cu); per_cu = 1; }
        (void)hipGetLastError();
        grid = cus * 1;
        fprintf(stderr, "kernel_launch: grid %d (cus %d, per_cu %d), ws %zu\n", grid, cus, per_cu, ws_size);
    }
    if (grid < 0) return;
    Params p{};
    for (int i = 0; i < 19; ++i) p.in[i] = (const float*)d_in[i];
    p.out = (float*)d_out; p.ws = (unsigned char*)d_ws;
#if N_LAUNCH_PER_PHASE
    for (int ph = 0; ph < NPHASE; ++ph) { p.ph_lo = ph; p.ph_hi = ph + 1; hipLaunchKernelGGL(fwd_kernel, dim3(grid), dim3(NTHREADS), LDS_BYTES, stream, p); }
#else
    p.ph_lo = 0; p.ph_hi = NPHASE;
    void* args[] = {&p};
    hipError_t e = hipLaunchCooperativeKernel((const void*)fwd_kernel, dim3(grid), dim3(NTHREADS), args, LDS_BYTES, stream);
    if (e != hipSuccess) fprintf(stderr, "cooperative launch failed: %s (grid %d)\n", hipGetErrorString(e), grid);
#endif
}
```

```cpp
#include <hip/hip_runtime.h>
#include <hip/hip_cooperative_groups.h>
#include <cstdio>
namespace cg = cooperative_groups;

#ifndef N_LAUNCH_PER_PHASE
#define N_LAUNCH_PER_PHASE 0
#endif

#define LAS __attribute__((address_space(3)))
typedef unsigned short bf16_t;
typedef short bf16x8 __attribute__((ext_vector_type(8)));
typedef float f32x4 __attribute__((ext_vector_type(4)));
typedef unsigned u32x4 __attribute__((ext_vector_type(4)));
typedef unsigned u32x2 __attribute__((ext_vector_type(2)));

constexpr int T = 81920, TP = 65536, D = 1024, DFF = 2816;
constexpr int NTHREADS = 512;
constexpr int LDS_BYTES = 147456;
constexpr int HTB = 16384;
constexpr float ALPHA = 1.41421356237309515f;
constexpr float LN_EPS = 1e-5f;

constexpr size_t MiB = 1ull << 20;
constexpr size_t WS_W = 1 * MiB;
constexpr size_t W_UP = 0;
constexpr size_t W_DN = 22 * MiB;
constexpr size_t W_IN = 33 * MiB;
constexpr size_t W_G = 36 * MiB;
constexpr size_t W_F = 44 * MiB;
constexpr size_t W_B = 45 * MiB;
constexpr size_t W_O = 47 * MiB;
constexpr size_t W_LAYER = 49 * MiB;
constexpr size_t WS_DFT4 = 99 * MiB;
constexpr size_t WS_DFT2 = 163 * MiB;
constexpr size_t WS_XB = 179 * MiB;
constexpr size_t WS_R = 339 * MiB;
constexpr size_t WS_H = WS_R;
constexpr size_t WS_Z = WS_R;
constexpr size_t WS_MRG = WS_R;
constexpr size_t WS_ZT = WS_R + 240 * MiB;
constexpr size_t WS_BR = WS_R + 320 * MiB;
constexpr size_t WS_SCR = WS_R + 480 * MiB;
constexpr size_t WS_XCH = 915 * MiB;
constexpr size_t WS_END = 918 * MiB;
constexpr size_t CTL_CNT = 4096;
constexpr int NPHASE = 19;

struct Params { const float* in[19]; float* out; unsigned char* ws; int ph_lo, ph_hi; };

typedef _Float16 h16x2_t __attribute__((ext_vector_type(2)));
typedef _Float16 h16x8_t __attribute__((ext_vector_type(8)));
typedef float f32x2_t __attribute__((ext_vector_type(2)));
__device__ __forceinline__ unsigned cvt_pk_h16(float lo, float hi) { const f32x2_t v = {lo, hi}; return __builtin_bit_cast(unsigned, __builtin_convertvector(v, h16x2_t)); }
__device__ __forceinline__ float hlo(unsigned w) { return (float)__builtin_bit_cast(h16x2_t, w).x; }
__device__ __forceinline__ float hhi(unsigned w) { return (float)__builtin_bit_cast(h16x2_t, w).y; }
typedef __bf16 tb16x2_t __attribute__((ext_vector_type(2)));
__device__ __forceinline__ unsigned cvt_pk_tb16(float lo, float hi) { const f32x2_t v = {lo, hi}; return __builtin_bit_cast(unsigned, __builtin_convertvector(v, tb16x2_t)); }
__device__ __forceinline__ unsigned cvt_pk_bf16(float lo, float hi) { return cvt_pk_tb16(lo, hi); }
__device__ __forceinline__ bf16_t f2bf(float f) { return (bf16_t)(cvt_pk_tb16(f, 0.f) & 0xffffu); }
__device__ __forceinline__ float bflo(unsigned w) { return __uint_as_float(w << 16); }
__device__ __forceinline__ float bfhi(unsigned w) { return __uint_as_float(w & 0xffff0000u); }
__device__ __forceinline__ float tblo(unsigned w) { return __uint_as_float(w << 16); }
__device__ __forceinline__ float tbhi(unsigned w) { return __uint_as_float(w & 0xffff0000u); }
__device__ __forceinline__ float sigmoid_f(float x) { return __builtin_amdgcn_rcpf(1.0f + __expf(-x)); }
__device__ __forceinline__ float gelu_tanh(float x) { return x * sigmoid_f(1.5957691216057308f * (x + 0.044715f * x * x * x)); }
__device__ __forceinline__ float silu_f(float x) { return x * sigmoid_f(x); }
__device__ __forceinline__ float wave_sum(float v, int lane) {
#pragma unroll
    for (int o = 32; o >= 1; o >>= 1) v += __int_as_float(__builtin_amdgcn_ds_bpermute((lane ^ o) << 2, __float_as_int(v)));
    return v;
}

__device__ __forceinline__ int lds_byte(int r, int c) { const int st = (r >> 4) * 2 + (c >> 5), rr = r & 15, cc = c & 31, ob = rr * 64 + cc * 2; return st * 1024 + (ob ^ (((ob >> 9) & 1) << 5)); }
__device__ __forceinline__ void stage_rc(int b, int& R, int& C) { const int st = b / 1024, sb = b % 1024, swz = sb ^ (((sb >> 9) & 1) << 5); R = (st >> 1) * 16 + swz / 64; C = (st & 1) * 32 + (swz % 64) / 2; }
__device__ __forceinline__ int perm32(int rho) { const int n = rho >> 4, i = rho & 15; return 8 * (i >> 2) + 4 * n + (i & 3); }

__device__ __forceinline__ bool tile_order(int L, int nM, int nN, int& pm, int& pn) {
    const int nwg = nM * nN; if (L >= nwg) return false;
    int wgid = L; { const int q = nwg / 8, r = nwg % 8, xcd = wgid % 8, off = wgid / 8; wgid = (xcd < r ? xcd * (q + 1) : r * (q + 1) + (xcd - r) * q) + off; }
    const int nig = 8 * nN, gid = wgid / nig, fm = gid * 8, gsz = (nM - fm) < 8 ? (nM - fm) : 8;
    pm = fm + ((wgid % nig) % gsz); pn = (wgid % nig) / gsz; return true;
}

struct Lane { int tid, wid, lane, wr, wc, fr, fq, bid; };
__device__ __forceinline__ int lane_id() { int l; asm volatile("v_mbcnt_lo_u32_b32 %0, -1, 0\n\tv_mbcnt_hi_u32_b32 %0, -1, %0" : "=v"(l)); return l; }
__device__ __forceinline__ Lane get_lane(int wv) { Lane l; l.tid = wv * 64 + lane_id(); asm volatile("" : "+v"(l.tid)); l.bid = blockIdx.x; asm volatile("" : "+s"(l.bid)); l.wid = l.tid >> 6; l.lane = l.tid & 63; l.wr = l.wid >> 2; l.wc = l.wid & 3; l.fr = l.lane & 15; l.fq = l.lane >> 4; return l; }

template <bool PERM>
__device__ __forceinline__ void gemm_tile(const Lane& L, LAS unsigned char* lds, const bf16_t* __restrict__ A, int lda, const bf16_t* __restrict__ B, int ldb, int nt, f32x4 (&acc)[2][2][4][2]) {
    const int tid = L.tid, wr = L.wr, wc = L.wc, fr = L.fr, fq = L.fq;
    unsigned voffA[2], voffB[2];
#pragma unroll
    for (int i = 0; i < 2; ++i) { int R, C; stage_rc(tid * 16 + i * 8192, R, C); const int Rb = PERM ? ((R & ~31) + perm32(R & 31)) : R; voffA[i] = (unsigned)(R * lda + C) * 2u; voffB[i] = (unsigned)(Rb * ldb + C) * 2u; }
    const unsigned ldsw = (unsigned)__builtin_amdgcn_readfirstlane(tid >> 6) * 1024u;
    const int aoff = lds_byte(wr * 64 + fr, fq * 8), boff = lds_byte(wc * 32 + fr, fq * 8);
    const char* Ab = (const char*)A; const char* Bb = (const char*)B; const size_t hA = (size_t)128 * lda * 2, hB = (size_t)128 * ldb * 2;
#define GT_STAGE(sb, t) do { _Pragma("unroll") for (int _h = 0; _h < 2; ++_h) { _Pragma("unroll") for (int _i = 0; _i < 2; ++_i) { \
        __builtin_amdgcn_global_load_lds((const unsigned*)(Ab + _h * hA + (size_t)(t) * 128 + voffA[_i]), (LAS unsigned*)(lds + (sb) * 65536 + _h * HTB + ldsw + _i * 8192), 16, 0, 0); \
        __builtin_amdgcn_global_load_lds((const unsigned*)(Bb + _h * hB + (size_t)(t) * 128 + voffB[_i]), (LAS unsigned*)(lds + (sb) * 65536 + (2 + _h) * HTB + ldsw + _i * 8192), 16, 0, 0); } } } while (0)
#pragma unroll
    for (int a = 0; a < 2; ++a)
#pragma unroll
        for (int b = 0; b < 2; ++b)
#pragma unroll
            for (int m = 0; m < 4; ++m)
#pragma unroll
                for (int n = 0; n < 2; ++n) acc[a][b][m][n] = (f32x4){0.f, 0.f, 0.f, 0.f};
    { int t0 = 0; asm volatile("" : "+s"(t0)); GT_STAGE(0, t0); }
    asm volatile("s_waitcnt vmcnt(0)" ::: "memory"); __syncthreads();
    for (int t = 0; t < nt; ++t) {
        const int sb = t & 1;
        if (t + 1 < nt) { int tn = t + 1; asm volatile("" : "+s"(tn)); GT_STAGE(sb ^ 1, tn); }
        LAS unsigned char* buf = lds + sb * 65536;
#pragma unroll
        for (int ai = 0; ai < 2; ++ai) {
            __builtin_amdgcn_sched_barrier(0);
            bf16x8 At[4][2];
#pragma unroll
            for (int m = 0; m < 4; ++m)
#pragma unroll
                for (int k = 0; k < 2; ++k) At[m][k] = *(const LAS bf16x8*)(buf + ai * HTB + aoff + m * 2048 + k * 1024);
#pragma unroll
            for (int bj = 0; bj < 2; ++bj) {
                __builtin_amdgcn_sched_barrier(0);
                bf16x8 Bf[2][2];
#pragma unroll
                for (int n = 0; n < 2; ++n)
#pragma unroll
                    for (int k = 0; k < 2; ++k) Bf[n][k] = *(const LAS bf16x8*)(buf + (2 + bj) * HTB + boff + n * 2048 + k * 1024);
#pragma unroll
                for (int m = 0; m < 4; ++m)
#pragma unroll
                    for (int n = 0; n < 2; ++n)
#pragma unroll
                        for (int k = 0; k < 2; ++k) acc[ai][bj][m][n] = __builtin_amdgcn_mfma_f32_16x16x32_bf16(Bf[n][k], At[m][k], acc[ai][bj][m][n], 0, 0, 0);
            }
        }
        asm volatile("s_waitcnt vmcnt(0)" ::: "memory"); __syncthreads();
    }
#undef GT_STAGE
}

struct GU { const char* A; const char* B; int pm, pn, K, aux; };
template <bool PERM, bool VARK, bool BF, class Next, class Epi>
__device__ __forceinline__ void gemm_stream(const Lane& L, LAS unsigned char* lds, const int K, const Next& next, const Epi& epi, f32x4 (&acc)[2][2][4][2]) {
    int tid = L.tid; asm volatile("" : "+v"(tid));
    const int wid = __builtin_amdgcn_readfirstlane(tid >> 6), wr = wid >> 2, wc = wid & 3, fr = tid & 15, fq = (tid >> 4) & 3;
    int nt = K / 64;
    unsigned voffA[2], voffB[2];
#pragma unroll
    for (int i = 0; i < 2; ++i) { int R, C; stage_rc(tid * 16 + i * 8192, R, C); const int Rb = PERM ? ((R & ~31) + perm32(R & 31)) : R; voffA[i] = (unsigned)(R * K + C) * 2u; voffB[i] = (unsigned)(Rb * K + C) * 2u; }
    const size_t kstep = 128; size_t hstep = (size_t)128 * K * 2;
    const unsigned ldsw = (unsigned)wid * 1024u;
    const int aoff = lds_byte(wr * 64 + fr, fq * 8), boff = lds_byte(wc * 32 + fr, fq * 8);
#define GS_SA(b, h) (((b) * 2 + (h)) * HTB)
#define GS_SB(b, h) ((4 + (b) * 2 + (h)) * HTB)
#define GS_STAGE(bufoff, gbase, voff) do { _Pragma("unroll") for (int _i = 0; _i < 2; ++_i) \
        __builtin_amdgcn_global_load_lds((const unsigned*)((const char*)(gbase) + (voff)[_i]), (LAS unsigned*)(lds + (bufoff) + ldsw + _i * 8192), 16, 0, 0); } while (0)
#define GS_LDA(dst, b, h) do { _Pragma("unroll") for (int m = 0; m < 4; ++m) _Pragma("unroll") for (int k = 0; k < 2; ++k) dst[m][k] = *(const LAS bf16x8*)(lds + GS_SA(b, h) + aoff + m * 2048 + k * 1024); } while (0)
#define GS_LDB(dst, b, h) do { _Pragma("unroll") for (int n = 0; n < 2; ++n) _Pragma("unroll") for (int k = 0; k < 2; ++k) dst[n][k] = *(const LAS bf16x8*)(lds + GS_SB(b, h) + boff + n * 2048 + k * 1024); } while (0)
#define GS_MMA(ai, bj, At_, Bt_) do { __builtin_amdgcn_s_setprio(1); _Pragma("unroll") for (int m = 0; m < 4; ++m) _Pragma("unroll") for (int n = 0; n < 2; ++n) _Pragma("unroll") for (int k = 0; k < 2; ++k) \
        acc[ai][bj][m][n] = __builtin_amdgcn_mfma_f32_16x16x32_bf16(Bt_[n][k], At_[m][k], acc[ai][bj][m][n], 0, 0, 0); __builtin_amdgcn_s_setprio(0); } while (0)
#define GS_WAIT_V(n) asm volatile("s_waitcnt vmcnt(" #n ")" ::: "memory")
#define GS_WAIT_L(n) asm volatile("s_waitcnt lgkmcnt(" #n ")" ::: "memory")
#define GS_BAR __builtin_amdgcn_s_barrier()
#define GS_SCHED __builtin_amdgcn_sched_barrier(0)
#define GS_ZERO() do { _Pragma("unroll") for (int a = 0; a < 2; ++a) _Pragma("unroll") for (int b = 0; b < 2; ++b) _Pragma("unroll") for (int m = 0; m < 4; ++m) _Pragma("unroll") for (int n = 0; n < 2; ++n) acc[a][b][m][n] = (f32x4){0.f, 0.f, 0.f, 0.f}; } while (0)
    GU cur, nxt; int ui = 0;
    if (!next(0, cur)) return;
    GS_ZERO();
    bf16x8 At[4][2], B0[2][2], B1[2][2];
    const char* cA = cur.A; const char* cB = cur.B;
    GS_STAGE(GS_SB(0, 0), cB, voffB); GS_STAGE(GS_SA(0, 0), cA, voffA); GS_STAGE(GS_SB(0, 1), cB + hstep, voffB); GS_STAGE(GS_SA(0, 1), cA + hstep, voffA);
    if (wr == 1) GS_BAR;
    GS_WAIT_V(4); GS_BAR;
    GS_STAGE(GS_SB(1, 0), cB + kstep, voffB); GS_STAGE(GS_SA(1, 0), cA + kstep, voffA); GS_STAGE(GS_SB(1, 1), cB + hstep + kstep, voffB);
    GS_WAIT_V(6); GS_BAR;
    for (;;) {
        const bool has_next = next(ui + 1, nxt);
        const char* nA = has_next ? nxt.A : cA; const char* nB = has_next ? nxt.B : cB;
        for (int t = 0; t < nt; t += 2) {
            const bool last = (t == nt - 2);
            const char* a1 = cA + (size_t)(t + 1) * kstep;
            const char* a2 = last ? nA : cA + (size_t)(t + 2) * kstep; const char* b2 = last ? nB : cB + (size_t)(t + 2) * kstep;
            const char* a3 = a2 + kstep; const char* b3 = b2 + kstep;
            GS_LDB(B0, 0, 0); GS_SCHED; GS_LDA(At, 0, 0); GS_STAGE(GS_SA(1, 1), a1 + hstep, voffA);
            if (VARK && last && has_next && nxt.K * 64 != nt * 4096) {
                int t2 = tid; asm volatile("" : "+v"(t2));
#pragma unroll
                for (int i = 0; i < 2; ++i) { int R, C; stage_rc(t2 * 16 + i * 8192, R, C); const int Rb = PERM ? ((R & ~31) + perm32(R & 31)) : R; voffA[i] = (unsigned)(R * nxt.K + C) * 2u; voffB[i] = (unsigned)(Rb * nxt.K + C) * 2u; }
                hstep = (size_t)128 * nxt.K * 2; }
            GS_WAIT_L(8); GS_BAR; GS_WAIT_L(0); GS_MMA(0, 0, At, B0); GS_BAR; GS_SCHED;
            GS_LDB(B1, 0, 1); GS_STAGE(GS_SB(0, 0), b2, voffB);
            GS_BAR; GS_WAIT_L(0); GS_MMA(0, 1, At, B1); GS_BAR;
            GS_LDA(At, 0, 1); GS_STAGE(GS_SA(0, 0), a2, voffA);
            GS_BAR; GS_WAIT_L(0); GS_MMA(1, 0, At, B0); GS_BAR; GS_SCHED;
            GS_STAGE(GS_SB(0, 1), b2 + hstep, voffB);
            GS_WAIT_V(6); GS_BAR; GS_MMA(1, 1, At, B1); GS_BAR;
            GS_LDB(B0, 1, 0); GS_SCHED; GS_LDA(At, 1, 0); GS_STAGE(GS_SA(0, 1), a2 + hstep, voffA);
            GS_WAIT_L(8); GS_BAR; GS_WAIT_L(0); GS_MMA(0, 0, At, B0); GS_BAR; GS_SCHED;
            GS_LDB(B1, 1, 1); GS_STAGE(GS_SB(1, 0), b3, voffB);
            GS_BAR; GS_WAIT_L(0); GS_MMA(0, 1, At, B1); GS_BAR;
            GS_LDA(At, 1, 1); GS_STAGE(GS_SA(1, 0), a3, voffA);
            GS_BAR; GS_WAIT_L(0); GS_MMA(1, 0, At, B0); GS_BAR; GS_SCHED;
            GS_STAGE(GS_SB(1, 1), b3 + hstep, voffB);
            GS_WAIT_V(6); GS_BAR; GS_MMA(1, 1, At, B1); GS_BAR;
        }
        epi(acc, cur);
        if (!has_next) break;
        GS_ZERO();
        cur = nxt; cA = nA; cB = nB; ++ui; if (VARK) nt = cur.K / 64;
    }
    GS_WAIT_V(0);
    if (wr == 0) GS_BAR;
    GS_BAR;
#undef GS_SA
#undef GS_SB
#undef GS_STAGE
#undef GS_LDA
#undef GS_LDB
#undef GS_MMA
#undef GS_WAIT_V
#undef GS_WAIT_L
#undef GS_BAR
#undef GS_SCHED
#undef GS_ZERO
}

__device__ __forceinline__ void transpose_job(const Lane& L, LAS float* tile, const float* __restrict__ src, int ld, int K, int N, bf16_t* __restrict__ dst, int dstld, int mapkind, int rowoff) {
    const int tn = N / 64, ntile = (K / 64) * tn;
    for (int tl = L.bid; tl < ntile; tl += gridDim.x) {
        const int k0 = (tl / tn) * 64, n0 = (tl % tn) * 64;
        __syncthreads();
#pragma unroll
        for (int h = 0; h < 2; ++h) { const int e = L.tid + h * NTHREADS, r = e >> 4, c4 = (e & 15) * 4; const f32x4 v = *(const f32x4*)(src + (size_t)(k0 + r) * ld + n0 + c4);
            tile[r * 65 + c4] = v[0]; tile[r * 65 + c4 + 1] = v[1]; tile[r * 65 + c4 + 2] = v[2]; tile[r * 65 + c4 + 3] = v[3]; }
        __syncthreads();
        { const int r = L.tid >> 3, c8 = (L.tid & 7) * 8, n = n0 + r;
          const int drow = (mapkind & 3) == 0 ? rowoff + n : ((n >> 7) * 256 + rowoff + (n & 127));
          float v[8];
#pragma unroll
          for (int j = 0; j < 8; ++j) v[j] = tile[(c8 + j) * 65 + r];
          u32x4 w;
          if (mapkind & 4) { w.x = cvt_pk_tb16(v[0], v[1]); w.y = cvt_pk_tb16(v[2], v[3]); w.z = cvt_pk_tb16(v[4], v[5]); w.w = cvt_pk_tb16(v[6], v[7]); }
          else { w.x = cvt_pk_bf16(v[0], v[1]); w.y = cvt_pk_bf16(v[2], v[3]); w.z = cvt_pk_bf16(v[4], v[5]); w.w = cvt_pk_bf16(v[6], v[7]); }
          *(u32x4*)(dst + (size_t)drow * dstld + k0 + c8) = w; }
    }
}

__device__ __forceinline__ void phase_prep(int wv, const Params& p, LAS unsigned char* lds) {
    LAS float* tile = (LAS float*)lds;
    LAS float* ctab = (LAS float*)(lds + 32768);
    const Lane L = get_lane(wv); const int tid = L.tid;
    if (tid < 64) ctab[tid] = cospif((float)tid * (1.0f / 32.0f));
    __syncthreads();
    const size_t gtid = (size_t)L.bid * NTHREADS + tid, gsz = (size_t)gridDim.x * NTHREADS;
    for (int l = 0; l < 2; ++l) {
        unsigned char* wl = p.ws + WS_W + (size_t)l * W_LAYER;
        for (int f = 0; f < 2; ++f) {
            transpose_job(L, tile, p.in[4] + (size_t)(l * 2 + f) * D * DFF, DFF, D, DFF, (bf16_t*)(wl + W_UP) + (size_t)f * 5632 * 1024, 1024, 1, 0);
            transpose_job(L, tile, p.in[5] + (size_t)(l * 2 + f) * D * DFF, DFF, D, DFF, (bf16_t*)(wl + W_UP) + (size_t)f * 5632 * 1024, 1024, 1, 128);
            transpose_job(L, tile, p.in[6] + (size_t)(l * 2 + f) * DFF * D, D, DFF, D, (bf16_t*)(wl + W_DN) + (size_t)f * 1024 * DFF, DFF, 4, 0);
        }
        const float* win = p.in[7] + (size_t)l * D * 1792;
        transpose_job(L, tile, win, 1792, D, 768, (bf16_t*)(wl + W_IN), 1024, 0, 0);
        transpose_job(L, tile, win + 1024, 1792, D, 512, (bf16_t*)(wl + W_IN), 1024, 0, 768);
        for (int i = 0; i < 4; ++i) {
            transpose_job(L, tile, p.in[15] + (size_t)(l * 4 + i) * D * D, D, D, D, (bf16_t*)(wl + W_G), 1024, 0, i * 1024);
            transpose_job(L, tile, p.in[17] + (size_t)(l * 4 + i) * 256 * D, D, 256, D, (bf16_t*)(wl + W_B) + (size_t)i * 1024 * 256, 256, 0, 0);
        }
        transpose_job(L, tile, p.in[18] + (size_t)l * D * D, D, D, D, (bf16_t*)(wl + W_O), 1024, 4, 0);
        { const float* pw = p.in[13] + (size_t)l * 4 * 64 * 64; const float* psc = p.in[14] + (size_t)l * 256; bf16_t* dst = (bf16_t*)(wl + W_IN);
          for (size_t idx = gtid; idx < 256 * 1024; idx += gsz) { const int n = (int)(idx & 255), d = (int)(idx >> 8), g = n >> 6, e = n & 63; float s = 0.f;
              const float* wr_ = win + (size_t)d * 1792 + 1536 + g * 64; const float* pg = pw + (size_t)g * 4096 + e;
              for (int c = 0; c < 64; ++c) s += wr_[c] * pg[c * 64];
              dst[(size_t)(1280 + n) * 1024 + d] = f2bf(s * psc[n]); } }
        { bf16_t* dst = (bf16_t*)(wl + W_F);
          for (size_t idx = gtid; idx < 512 * 1024; idx += gsz) { const int n = (int)(idx & 511), d = (int)(idx >> 9), part = n >> 8, hh = (n >> 6) & 3, mm = n & 63; float s = 0.f;
              const float* wr_ = win + (size_t)d * 1792 + 768 + hh * 64; const int sh = part ? 16 : 0;
              for (int c = 0; c < 64; ++c) s += wr_[c] * ctab[((mm * c) - sh) & 63];
              dst[(size_t)n * 1024 + d] = f2bf(s); } }
    }
    { bf16_t* d4 = (bf16_t*)(p.ws + WS_DFT4);
      for (size_t idx = gtid; idx < (size_t)4096 * 512; idx += gsz) { const int k = (int)(idx >> 9), c8 = (int)(idx & 511) * 8; float v[8];
#pragma unroll
          for (int e = 0; e < 8; ++e) { const int col = c8 + e, sp = col & 2047, j = (k * sp) & 4095; const float x = (float)j * (1.0f / 2048.0f); v[e] = (col >> 11) ? -sinpif(x) : cospif(x); }
          u32x4 w; w.x = cvt_pk_tb16(v[0], v[1]); w.y = cvt_pk_tb16(v[2], v[3]); w.z = cvt_pk_tb16(v[4], v[5]); w.w = cvt_pk_tb16(v[6], v[7]);
          *(u32x4*)(d4 + (size_t)k * 4096 + c8) = w; }
      bf16_t* d2 = (bf16_t*)(p.ws + WS_DFT2);
      for (size_t idx = gtid; idx < (size_t)2048 * 256; idx += gsz) { const int k = (int)(idx >> 8), c8 = (int)(idx & 255) * 8; float v[8];
#pragma unroll
          for (int e = 0; e < 8; ++e) { const int col = c8 + e, sp = col & 1023, j = (k * sp) & 2047; const float x = (float)j * (1.0f / 1024.0f); v[e] = (col >> 10) ? -sinpif(x) : cospif(x); }
          u32x4 w; w.x = cvt_pk_tb16(v[0], v[1]); w.y = cvt_pk_tb16(v[2], v[3]); w.z = cvt_pk_tb16(v[4], v[5]); w.w = cvt_pk_tb16(v[6], v[7]);
          *(u32x4*)(d2 + (size_t)k * 2048 + c8) = w; } }
    { const f32x4* xp = (const f32x4*)p.in[0]; const f32x4* xs = (const f32x4*)p.in[1]; u32x2* xb = (u32x2*)(p.ws + WS_XB);
      for (size_t idx = gtid; idx < (size_t)T * 256; idx += gsz) { const f32x4 v = idx < (size_t)TP * 256 ? xp[idx] : xs[idx - (size_t)TP * 256];
          u32x2 w; w.x = cvt_pk_h16(v[0], v[1]); w.y = cvt_pk_h16(v[2], v[3]); xb[idx] = w;
          u32x2 w2; w2.x = cvt_pk_bf16(v[0], v[1]); w2.y = cvt_pk_bf16(v[2], v[3]); ((u32x2*)p.out)[idx] = w2; } }
}

__device__ __forceinline__ void phase_ln(int wv, const Params& p, int l, int which) {
    const Lane L = get_lane(wv);
    const float* g = p.in[2] + (size_t)(l * 3 + which) * 1024; const float* b = p.in[3] + (size_t)(l * 3 + which) * 1024;
    f32x4 gv[4], bv[4];
#pragma unroll
    for (int j = 0; j < 4; ++j) { gv[j] = *(const f32x4*)(g + j * 256 + L.lane * 4); bv[j] = *(const f32x4*)(b + j * 256 + L.lane * 4); }
    bf16_t* xb = (bf16_t*)(p.ws + WS_XB);
    for (int row = L.bid * 8 + L.wid; row < T; row += gridDim.x * 8) {
        float* rp = p.out + (size_t)row * 1024 + L.lane * 4; f32x4 v[4]; float s = 0.f;
#pragma unroll
        for (int j = 0; j < 4; ++j) { v[j] = *(const f32x4*)(rp + j * 256); s += (v[j][0] + v[j][1]) + (v[j][2] + v[j][3]); }
        const float mean = wave_sum(s, L.lane) * (1.0f / 1024.0f); float q = 0.f;
#pragma unroll
        for (int j = 0; j < 4; ++j) { const f32x4 d = v[j] - mean; q += (d[0] * d[0] + d[1] * d[1]) + (d[2] * d[2] + d[3] * d[3]); }
        const float rstd = rsqrtf(wave_sum(q, L.lane) * (1.0f / 1024.0f) + LN_EPS);
#pragma unroll
        for (int j = 0; j < 4; ++j) { const f32x4 o = (v[j] - mean) * rstd * gv[j] + bv[j]; *(f32x4*)(rp + j * 256) = o;
            u32x2 w; w.x = cvt_pk_bf16(o[0], o[1]); w.y = cvt_pk_bf16(o[2], o[3]); *(u32x2*)(xb + (size_t)row * 1024 + j * 256 + L.lane * 4) = w; }
    }
}

__device__ __forceinline__ u32x4 pack8_tb(const f32x4& a, const f32x4& b) { u32x4 w; w.x = cvt_pk_tb16(a[0], a[1]); w.y = cvt_pk_tb16(a[2], a[3]); w.z = cvt_pk_tb16(b[0], b[1]); w.w = cvt_pk_tb16(b[2], b[3]); return w; }
__device__ __forceinline__ u32x4 pack8(const f32x4& a, const f32x4& b) { u32x4 w; w.x = cvt_pk_bf16(a[0], a[1]); w.y = cvt_pk_bf16(a[2], a[3]); w.z = cvt_pk_bf16(b[0], b[1]); w.w = cvt_pk_bf16(b[2], b[3]); return w; }

__device__ __forceinline__ void phase_ffn_up(int wv, const Params& p, LAS unsigned char* lds, int l, int f) {
    const Lane L = get_lane(wv);
    const bf16_t* xb = (const bf16_t*)p.out; const bf16_t* W = (const bf16_t*)(p.ws + WS_W + (size_t)l * W_LAYER + W_UP) + (size_t)f * 5632 * 1024; bf16_t* H = (bf16_t*)(p.ws + WS_H);
    const int G = gridDim.x, bid = L.bid;
    auto next = [=](int i, GU& u) -> bool { int pm, pn; if (!tile_order(i * G + bid, 320, 22, pm, pn)) return false;
        u.A = (const char*)(xb + (size_t)pm * 256 * 1024); u.B = (const char*)(W + (size_t)pn * 256 * 1024); u.pm = pm; u.pn = pn; return true; };
    auto epi = [=](f32x4 (&acc)[2][2][4][2], const GU& u) {
        const int row0 = u.pm * 256 + L.wr * 64 + L.fr, col0 = u.pn * 128 + L.wc * 32 + 8 * L.fq;
#pragma unroll
        for (int ai = 0; ai < 2; ++ai)
#pragma unroll
            for (int m = 0; m < 4; ++m) { f32x4 o[2];
#pragma unroll
                for (int n = 0; n < 2; ++n)
#pragma unroll
                    for (int j = 0; j < 4; ++j) o[n][j] = silu_f(acc[ai][0][m][n][j]) * acc[ai][1][m][n][j];
                *(u32x4*)(H + (size_t)(row0 + ai * 128 + m * 16) * DFF + col0) = pack8_tb(o[0], o[1]); }
    };
    { f32x4 acc_[2][2][4][2]; gemm_stream<true, false, false>(L, lds, 1024, next, epi, acc_); }
}

__device__ __forceinline__ float lane_xor_add(float v, int lane, int mask) { return v + __int_as_float(__builtin_amdgcn_ds_bpermute((lane ^ mask) << 2, __float_as_int(v))); }
__device__ __forceinline__ void phase_down_ln(int wv, const Params& p, LAS unsigned char* lds, const bf16_t* A, int K, const bf16_t* W, float cscale, int l, int which) {
    typedef float f32x2v __attribute__((ext_vector_type(2)));
    const Lane L = get_lane(wv);
    const int wid = __builtin_amdgcn_readfirstlane(L.tid >> 6), lane = L.lane, wr = L.wr, wc = L.wc, fr = L.fr, fq = L.fq;
    float* out = p.out; bf16_t* xb = (bf16_t*)(p.ws + WS_XB);
    unsigned long long* xch = (unsigned long long*)(p.ws + WS_XCH); unsigned* cnt = (unsigned*)(p.ws + CTL_CNT);
    const float* lg = p.in[2] + (size_t)(l * 3 + which) * 1024; const float* lb = p.in[3] + (size_t)(l * 3 + which) * 1024;
    const unsigned tag = (unsigned)(l * 3 + which + 1);
    LAS f32x2v* P = (LAS f32x2v*)lds; LAS f32x2v* S = (LAS f32x2v*)(lds + 8192);
    const int nround = (1280 + (int)gridDim.x - 1) / (int)gridDim.x;
    for (int it = 0; it < nround; ++it) { int pm, pn;
        if (!tile_order((nround - 1 - it) * gridDim.x + L.bid, 320, 4, pm, pn)) continue;
        f32x4 acc[2][2][4][2];
        { auto next = [=](int k, GU& u) -> bool { if (k > 0) return false; u.A = (const char*)(A + (size_t)pm * 256 * K); u.B = (const char*)(W + (size_t)pn * 256 * K); u.pm = pm; u.pn = pn; return true; };
          auto epi = [=](f32x4 (&)[2][2][4][2], const GU&) {};
          gemm_stream<true, false, true>(L, lds, K, next, epi, acc); }
        int row0 = pm * 256 + wr * 64 + fr; asm volatile("" : "+v"(row0));
        const int col0 = pn * 256 + wc * 32 + 8 * fq;
        {
#pragma unroll
            for (int ai = 0; ai < 2; ++ai) {
                u32x4 xr[4][2];
#pragma unroll
                for (int m = 0; m < 4; ++m)
#pragma unroll
                    for (int bj = 0; bj < 2; ++bj) xr[m][bj] = *(const u32x4*)(xb + (size_t)(row0 + ai * 128 + m * 16) * 1024 + col0 + bj * 128);
#pragma unroll
                for (int m = 0; m < 4; ++m)
#pragma unroll
                    for (int bj = 0; bj < 2; ++bj) { const u32x4 w = xr[m][bj];
                        acc[ai][bj][m][0] = (f32x4){hlo(w.x), hhi(w.x), hlo(w.y), hhi(w.y)} * ALPHA + acc[ai][bj][m][0] * cscale;
                        acc[ai][bj][m][1] = (f32x4){hlo(w.z), hhi(w.z), hlo(w.w), hhi(w.w)} * ALPHA + acc[ai][bj][m][1] * cscale; }
#pragma unroll
                for (int m = 0; m < 4; ++m) asm volatile("" : "+v"(acc[ai][0][m][0]), "+v"(acc[ai][0][m][1]), "+v"(acc[ai][1][m][0]), "+v"(acc[ai][1][m][1]));
                asm volatile("" ::: "memory"); }
        }
#pragma unroll
        for (int ai = 0; ai < 2; ++ai)
#pragma unroll
            for (int m = 0; m < 4; ++m) { float sm = 0.f;
#pragma unroll
                for (int bj = 0; bj < 2; ++bj)
#pragma unroll
                    for (int n = 0; n < 2; ++n) { const f32x4 x = acc[ai][bj][m][n]; sm += (x[0] + x[1]) + (x[2] + x[3]); }
                sm = lane_xor_add(sm, lane, 16); sm = lane_xor_add(sm, lane, 32);
                const float mw = sm * (1.0f / 64.0f); float q = 0.f;
#pragma unroll
                for (int bj = 0; bj < 2; ++bj)
#pragma unroll
                    for (int n = 0; n < 2; ++n) { const f32x4 d = acc[ai][bj][m][n] - mw; q += (d[0] * d[0] + d[1] * d[1]) + (d[2] * d[2] + d[3] * d[3]); }
                q = lane_xor_add(q, lane, 16); q = lane_xor_add(q, lane, 32);
                if (fq == 0) P[(ai * 128 + wr * 64 + m * 16 + fr) * 4 + wc] = (f32x2v){mw, q}; }
        __syncthreads();
        const int row = wid * 32 + (lane & 31);
        if (lane < 32) { const f32x2v a = P[row * 4 + 0], b = P[row * 4 + 1], c = P[row * 4 + 2], d = P[row * 4 + 3];
            const float mt = (a.x + b.x + c.x + d.x) * 0.25f; const float da = a.x - mt, db = b.x - mt, dc = c.x - mt, dd = d.x - mt;
            const float m2 = (a.y + b.y) + (c.y + d.y) + 64.0f * ((da * da + db * db) + (dc * dc + dd * dd));
            __hip_atomic_store(xch + ((size_t)(pm * 256 + row) * 4 + pn), ((unsigned long long)((__float_as_uint(m2) & 0xffffff00u) | tag) << 32) | __float_as_uint(mt), __ATOMIC_RELAXED, __HIP_MEMORY_SCOPE_AGENT);
            const unsigned long long* slot = xch + (size_t)(pm * 256 + row) * 4; unsigned long long w[4];
            for (unsigned polls = 0; polls < (1u << 18); ++polls) { bool ok = true;
#pragma unroll
                for (int t = 0; t < 4; ++t) { w[t] = __hip_atomic_load(slot + t, __ATOMIC_RELAXED, __HIP_MEMORY_SCOPE_AGENT); ok = ok && (((unsigned)(w[t] >> 32) & 0xffu) == tag); }
                if (ok) break;
                __builtin_amdgcn_s_sleep(1); }
            float mtt[4], m2t[4], ms = 0.f;
#pragma unroll
            for (int t = 0; t < 4; ++t) { mtt[t] = __uint_as_float((unsigned)w[t]); m2t[t] = __uint_as_float((unsigned)(w[t] >> 32) & 0xffffff00u); ms += mtt[t]; }
            const float mean = ms * 0.25f; float q = 0.f;
#pragma unroll
            for (int t = 0; t < 4; ++t) { const float dm = mtt[t] - mean; q += m2t[t] + 256.0f * dm * dm; }
            S[row] = (f32x2v){mean, rsqrtf(q * (1.0f / 1024.0f) + LN_EPS)}; }
        __syncthreads();
        int col0o = col0; asm volatile("" : "+v"(col0o));
        const bool fin = (l == 1 && which == 2);
#pragma unroll
        for (int bj = 0; bj < 2; ++bj) {
            const f32x4 g0 = *(const f32x4*)(lg + col0o + bj * 128), g1 = *(const f32x4*)(lg + col0o + bj * 128 + 4), b0 = *(const f32x4*)(lb + col0o + bj * 128), b1 = *(const f32x4*)(lb + col0o + bj * 128 + 4);
#pragma unroll
            for (int ai = 0; ai < 2; ++ai)
#pragma unroll
                for (int m = 0; m < 4; ++m) { const int r = ai * 128 + wr * 64 + m * 16 + fr; const f32x2v sr = S[r]; const size_t off = (size_t)(pm * 256 + r) * 1024 + col0o + bj * 128;
                    const f32x4 o0 = (acc[ai][bj][m][0] - sr.x) * sr.y * g0 + b0, o1 = (acc[ai][bj][m][1] - sr.x) * sr.y * g1 + b1;
                    if (fin) { *(f32x4*)(out + off) = o0; *(f32x4*)(out + off + 4) = o1; }
                    else { u32x4 wh; wh.x = cvt_pk_h16(o0[0], o0[1]); wh.y = cvt_pk_h16(o0[2], o0[3]); wh.z = cvt_pk_h16(o1[0], o1[1]); wh.w = cvt_pk_h16(o1[2], o1[3]);
                        *(u32x4*)(xb + off) = wh; *(u32x4*)((bf16_t*)out + off) = pack8(o0, o1); } }
            asm volatile("" ::: "memory"); }
        __syncthreads();
    }
}

__device__ __forceinline__ void phase_mix_in(int wv, const Params& p, LAS unsigned char* lds, int l) {
    const Lane L = get_lane(wv);
    const bf16_t* xb = (const bf16_t*)p.out; const unsigned char* wl = p.ws + WS_W + (size_t)l * W_LAYER;
    const bf16_t* Win = (const bf16_t*)(wl + W_IN); const bf16_t* Wf = (const bf16_t*)(wl + W_F);
    bf16_t* Z = (bf16_t*)(p.ws + WS_Z); bf16_t* ZT = (bf16_t*)(p.ws + WS_ZT);
    const int G = gridDim.x, bid = L.bid;
    {
        auto next = [=](int i, GU& u) -> bool { int pm, pn; if (!tile_order(i * G + bid, 320, 6, pm, pn)) return false;
            u.A = (const char*)(xb + (size_t)pm * 256 * 1024); u.B = (const char*)(Win + (size_t)pn * 256 * 1024); u.pm = pm; u.pn = pn; return true; };
        auto epi = [=](f32x4 (&acc)[2][2][4][2], const GU& u) {
            const int row0 = u.pm * 256 + L.wr * 64 + L.fr, col0 = u.pn * 256 + L.wc * 32 + 8 * L.fq; const bool act = (u.pn == 3 || u.pn == 4);
#pragma unroll
            for (int ai = 0; ai < 2; ++ai)
#pragma unroll
                for (int m = 0; m < 4; ++m)
#pragma unroll
                    for (int bj = 0; bj < 2; ++bj) { f32x4 o0 = acc[ai][bj][m][0], o1 = acc[ai][bj][m][1];
                        if (act) {
#pragma unroll
                            for (int j = 0; j < 4; ++j) { o0[j] = gelu_tanh(o0[j]); o1[j] = gelu_tanh(o1[j]); } }
                        *(u32x4*)(Z + (size_t)(row0 + ai * 128 + m * 16) * 1536 + col0 + bj * 128) = pack8(o0, o1); }
        };
        { f32x4 acc_[2][2][4][2]; gemm_stream<true, false, false>(L, lds, 1024, next, epi, acc_); }
    }
    {
        auto next = [=](int i, GU& u) -> bool { int pm, pn; if (!tile_order(i * G + bid, 320, 2, pm, pn)) return false;
            u.A = (const char*)(Wf + (size_t)pn * 256 * 1024); u.B = (const char*)(xb + (size_t)pm * 256 * 1024); u.pm = pm; u.pn = pn; return true; };
        auto epi = [=](f32x4 (&acc)[2][2][4][2], const GU& u) {
            const int tok0 = u.pm * 256, part = u.pn;
            size_t base; int S;
            if (tok0 < TP) { S = 4096; base = (size_t)(tok0 >> 12) * 256 * 2 * 4096 + (tok0 & 4095); }
            else { S = 2048; const int t2 = tok0 - TP; base = (size_t)TP * 512 + (size_t)(t2 >> 11) * 256 * 2 * 2048 + (t2 & 2047); }
#pragma unroll
            for (int ai = 0; ai < 2; ++ai)
#pragma unroll
                for (int m = 0; m < 4; ++m) { const int colc = ai * 128 + L.wr * 64 + m * 16 + L.fr;
#pragma unroll
                    for (int bj = 0; bj < 2; ++bj)
                        *(u32x4*)(ZT + base + (size_t)(colc * 2 + part) * S + bj * 128 + L.wc * 32 + 8 * L.fq) = pack8_tb(acc[ai][bj][m][0], acc[ai][bj][m][1]); }
        };
        { f32x4 acc_[2][2][4][2]; gemm_stream<true, false, false>(L, lds, 1024, next, epi, acc_); }
    }
}

__device__ __forceinline__ void phase_fold(int wv, const Params& p) {
    const Lane L = get_lane(wv);
    const bf16_t* ZT = (const bf16_t*)(p.ws + WS_ZT); bf16_t* ZF = (bf16_t*)(p.ws + WS_SCR);
    const size_t gtid = (size_t)L.bid * NTHREADS + L.tid, gsz = (size_t)gridDim.x * NTHREADS;
    for (size_t idx = gtid; idx < (size_t)4096 * 512 + (size_t)2048 * 256; idx += gsz) {
        int S, row, part, o; const bf16_t* zrow; bf16_t* frow;
        if (idx < (size_t)4096 * 512) { S = 4096; row = (int)(idx >> 9); part = (int)(idx >> 8) & 1; o = (int)(idx & 255) * 8; zrow = ZT + ((size_t)row * 2 + part) * 4096; frow = ZF + (size_t)row * 4096 + part * 2048; }
        else { const size_t i2 = idx - (size_t)4096 * 512; S = 2048; row = (int)(i2 >> 8); part = (int)(i2 >> 7) & 1; o = (int)(i2 & 127) * 8;
               zrow = ZT + (size_t)TP * 512 + ((size_t)row * 2 + part) * 2048; frow = ZF + (size_t)TP * 256 + (size_t)row * 2048 + part * 1024; }
        const u32x4 a = *(const u32x4*)(zrow + o);
        const u32x4 v1 = *(const u32x4*)(zrow + S - o - 8);
        const unsigned v2 = o > 0 ? *(const unsigned*)(zrow + S - o) : 0u;
        float z[8], mz[8];
        z[0] = tblo(a.x); z[1] = tbhi(a.x); z[2] = tblo(a.y); z[3] = tbhi(a.y); z[4] = tblo(a.z); z[5] = tbhi(a.z); z[6] = tblo(a.w); z[7] = tbhi(a.w);
        mz[0] = tblo(v2); mz[1] = tbhi(v1.w); mz[2] = tblo(v1.w); mz[3] = tbhi(v1.z); mz[4] = tblo(v1.z); mz[5] = tbhi(v1.y); mz[6] = tblo(v1.y); mz[7] = tbhi(v1.x);
        float r[8];
#pragma unroll
        for (int j = 0; j < 8; ++j) r[j] = part ? z[j] - mz[j] : z[j] + mz[j];
        if (part && o == 0) r[0] = 0.f;
        u32x4 w; w.x = cvt_pk_tb16(r[0], r[1]); w.y = cvt_pk_tb16(r[2], r[3]); w.z = cvt_pk_tb16(r[4], r[5]); w.w = cvt_pk_tb16(r[6], r[7]);
        *(u32x4*)(frow + o) = w;
    }
}

__device__ __forceinline__ void phase_dft(int wv, const Params& p, LAS unsigned char* lds) {
    const Lane L = get_lane(wv);
    const bf16_t* ZT = (const bf16_t*)(p.ws + WS_ZT); const bf16_t* ZF = (const bf16_t*)(p.ws + WS_SCR); bf16_t* BR1 = (bf16_t*)(p.ws + WS_BR) + (size_t)1 * T * 256;
    const bf16_t* D4 = (const bf16_t*)(p.ws + WS_DFT4); const bf16_t* D2 = (const bf16_t*)(p.ws + WS_DFT2);
    const int G = gridDim.x, bid = L.bid;
    {
        auto next = [=](int i, GU& u) -> bool { const int v = i * G + bid; if (v >= 256) return false; const int b = v >> 4, pm = v & 15;
            u.A = (const char*)(D4 + (size_t)pm * 256 * 4096); u.B = (const char*)(ZF + (size_t)b * 256 * 4096); u.pm = b * 4096 + pm * 256; u.pn = b; return true; };
        auto epi = [=](f32x4 (&acc)[2][2][4][2], const GU& u) {
            const int row0 = u.pm + L.wr * 64 + L.fr, col0 = L.wc * 32 + 8 * L.fq; const float scale = 1.0f / 512.0f, sg = (L.fr & 1) ? -scale : scale;
#pragma unroll
            for (int bj = 0; bj < 2; ++bj) { f32x4 h0, h1;
#pragma unroll
                for (int j = 0; j < 4; ++j) { h0[j] = sg * tblo((unsigned)ZT[((size_t)(u.pn * 256 + col0 + bj * 128 + j) * 2) * 4096 + 2048]); h1[j] = sg * tblo((unsigned)ZT[((size_t)(u.pn * 256 + col0 + bj * 128 + 4 + j) * 2) * 4096 + 2048]); }
#pragma unroll
                for (int ai = 0; ai < 2; ++ai)
#pragma unroll
                    for (int m = 0; m < 4; ++m)
                        *(u32x4*)(BR1 + (size_t)(row0 + ai * 128 + m * 16) * 256 + col0 + bj * 128) = pack8(acc[ai][bj][m][0] * scale + h0, acc[ai][bj][m][1] * scale + h1); }
        };
        { f32x4 acc_[2][2][4][2]; gemm_stream<true, false, true>(L, lds, 4096, next, epi, acc_); }
    }
    {
        auto next = [=](int i, GU& u) -> bool { const int v = i * G + (G - 1 - bid); if (v >= 64) return false; const int b = v >> 3, pm = v & 7;
            u.A = (const char*)(D2 + (size_t)pm * 256 * 2048); u.B = (const char*)(ZF + (size_t)TP * 256 + (size_t)b * 256 * 2048); u.pm = TP + b * 2048 + pm * 256; u.pn = b; return true; };
        auto epi = [=](f32x4 (&acc)[2][2][4][2], const GU& u) {
            const int row0 = u.pm + L.wr * 64 + L.fr, col0 = L.wc * 32 + 8 * L.fq; const float scale = 0.00276213586400995f, sg = (L.fr & 1) ? -scale : scale;
#pragma unroll
            for (int bj = 0; bj < 2; ++bj) { f32x4 h0, h1;
#pragma unroll
                for (int j = 0; j < 4; ++j) { h0[j] = sg * tblo((unsigned)ZT[(size_t)TP * 512 + ((size_t)(u.pn * 256 + col0 + bj * 128 + j) * 2) * 2048 + 1024]); h1[j] = sg * tblo((unsigned)ZT[(size_t)TP * 512 + ((size_t)(u.pn * 256 + col0 + bj * 128 + 4 + j) * 2) * 2048 + 1024]); }
#pragma unroll
                for (int ai = 0; ai < 2; ++ai)
#pragma unroll
                    for (int m = 0; m < 4; ++m)
                        *(u32x4*)(BR1 + (size_t)(row0 + ai * 128 + m * 16) * 256 + col0 + bj * 128) = pack8(acc[ai][bj][m][0] * scale + h0, acc[ai][bj][m][1] * scale + h1); }
        };
        { f32x4 acc_[2][2][4][2]; gemm_stream<true, false, true>(L, lds, 2048, next, epi, acc_); }
    }
}

__device__ __forceinline__ void phase_mixers(int wv, const Params& p, LAS unsigned char* lds, int l) {
    const Lane L = get_lane(wv); const int tid = L.tid;
    const bf16_t* Z = (const bf16_t*)(p.ws + WS_Z);
    bf16_t* BR0 = (bf16_t*)(p.ws + WS_BR); bf16_t* BR2 = BR0 + (size_t)2 * T * 256; bf16_t* BR3 = BR0 + (size_t)3 * T * 256;
    const size_t gtid = (size_t)L.bid * NTHREADS + tid, gsz = (size_t)gridDim.x * NTHREADS;
    const float* cw = p.in[8] + (size_t)l * 3 * 256;
    for (size_t idx = gtid; idx < (size_t)T * 32; idx += gsz) {
        const int t = (int)(idx >> 5), c8 = (int)(idx & 31) * 8; int s, S; if (t < TP) { s = t & 4095; S = 4096; } else { s = (t - TP) & 2047; S = 2048; }
        const bf16_t* zr = Z + (size_t)t * 1536 + c8;
        { const u32x4 hv = *(const u32x4*)zr, gb = *(const u32x4*)(zr + 256), gc = *(const u32x4*)(zr + 512);
          u32x4 hp = (u32x4){0u, 0u, 0u, 0u}, cp = hp, hn = hp, cn = hp;
          if (s > 0) { hp = *(const u32x4*)(zr - 1536); cp = *(const u32x4*)(zr - 1536 + 512); }
          if (s + 1 < S) { hn = *(const u32x4*)(zr + 1536); cn = *(const u32x4*)(zr + 1536 + 512); }
          const f32x4 w0a = *(const f32x4*)(cw + c8), w0b = *(const f32x4*)(cw + c8 + 4), w1a = *(const f32x4*)(cw + 256 + c8), w1b = *(const f32x4*)(cw + 256 + c8 + 4), w2a = *(const f32x4*)(cw + 512 + c8), w2b = *(const f32x4*)(cw + 512 + c8 + 4);
          float o[8];
#pragma unroll
          for (int e = 0; e < 4; ++e) {
              const float k0l = e < 2 ? w0a[2 * e] : w0b[2 * e - 4], k0h = e < 2 ? w0a[2 * e + 1] : w0b[2 * e - 3];
              const float k1l = e < 2 ? w1a[2 * e] : w1b[2 * e - 4], k1h = e < 2 ? w1a[2 * e + 1] : w1b[2 * e - 3];
              const float k2l = e < 2 ? w2a[2 * e] : w2b[2 * e - 4], k2h = e < 2 ? w2a[2 * e + 1] : w2b[2 * e - 3];
              o[2 * e] = bflo(gb[e]) * (k0l * bflo(cp[e]) * bflo(hp[e]) + k1l * bflo(gc[e]) * bflo(hv[e]) + k2l * bflo(cn[e]) * bflo(hn[e]));
              o[2 * e + 1] = bfhi(gb[e]) * (k0h * bfhi(cp[e]) * bfhi(hp[e]) + k1h * bfhi(gc[e]) * bfhi(hv[e]) + k2h * bfhi(cn[e]) * bfhi(hn[e])); }
          u32x4 w; w.x = cvt_pk_bf16(o[0], o[1]); w.y = cvt_pk_bf16(o[2], o[3]); w.z = cvt_pk_bf16(o[4], o[5]); w.w = cvt_pk_bf16(o[6], o[7]);
          *(u32x4*)(BR0 + (size_t)t * 256 + c8) = w; }
        { const int half = 1 << (c8 >> 6); const int lo = s - half < 0 ? 0 : s - half, hi = s + half > S ? S : s + half;
          u32x4 pv[16];
#pragma unroll
          for (int jj = 0; jj < 16; ++jj) { const int j = s - half + jj; const bool ok = jj < 2 * half && j >= 0 && j < S;
              pv[jj] = ok ? *(const u32x4*)(zr + 1280 + (ptrdiff_t)(j - s) * 1536) : (u32x4){0u, 0u, 0u, 0u}; }
          float sum[8];
#pragma unroll
          for (int e = 0; e < 8; ++e) sum[e] = 0.f;
#pragma unroll
          for (int jj = 0; jj < 16; ++jj) {
#pragma unroll
              for (int e = 0; e < 4; ++e) { sum[2 * e] += bflo(pv[jj][e]); sum[2 * e + 1] += bfhi(pv[jj][e]); } }
          const float inv = 1.0f / (float)(hi - lo); const u32x4 zc = *(const u32x4*)(zr + 1280);
          u32x4 w;
#pragma unroll
          for (int e = 0; e < 4; ++e) w[e] = cvt_pk_bf16(sum[2 * e] * inv - bflo(zc[e]), sum[2 * e + 1] * inv - bfhi(zc[e]));
          *(u32x4*)(BR3 + (size_t)t * 256 + c8) = w; }
    }
    LAS bf16_t* VT = (LAS bf16_t*)lds;
    LAS float* red = (LAS float*)(lds + 69632);
    const float* lg = p.in[9] + (size_t)l * 256; const float* lb = p.in[10] + (size_t)l * 256;
    const float* sw = p.in[11] + (size_t)l * 4 * 128 * 128; const float* sb = p.in[12] + (size_t)l * 4 * 128;
    for (int ch = L.bid; ch < T / 128; ch += gridDim.x) {
        const int t0 = ch * 128, q = tid & 127, part = tid >> 7;
        const bf16_t* vp = Z + (size_t)(t0 + q) * 1536 + 1024 + part * 64;
        __syncthreads();
        float s = 0.f, ss = 0.f;
#pragma unroll
        for (int j = 0; j < 8; ++j) { const u32x4 w = *(const u32x4*)(vp + j * 8);
#pragma unroll
            for (int e = 0; e < 4; ++e) { const float a = bflo(w[e]), b = bfhi(w[e]); s += a + b; ss += a * a + b * b; } }
        red[(part * 128 + q) * 2] = s; red[(part * 128 + q) * 2 + 1] = ss;
        __syncthreads();
        float S1 = 0.f, S2 = 0.f;
#pragma unroll
        for (int pp = 0; pp < 4; ++pp) { S1 += red[(pp * 128 + q) * 2]; S2 += red[(pp * 128 + q) * 2 + 1]; }
        const float mean = S1 * (1.0f / 256.0f), var = S2 * (1.0f / 256.0f) - mean * mean, rstd = rsqrtf((var > 0.f ? var : 0.f) + LN_EPS);
#pragma unroll
        for (int j = 0; j < 8; ++j) { const u32x4 w = *(const u32x4*)(vp + j * 8); const int c0 = part * 64 + j * 8;
#pragma unroll
            for (int e = 0; e < 4; ++e) { const float a = (bflo(w[e]) - mean) * rstd * lg[c0 + 2 * e] + lb[c0 + 2 * e], b = (bfhi(w[e]) - mean) * rstd * lg[c0 + 2 * e + 1] + lb[c0 + 2 * e + 1];
                VT[(c0 + 2 * e) * 136 + q] = f2bf(a); VT[(c0 + 2 * e + 1) * 136 + q] = f2bf(b); } }
        __syncthreads();
        const int hh = L.wid >> 1, ph = L.wid & 1;
        f32x4 a2[4][4];
#pragma unroll
        for (int ct = 0; ct < 4; ++ct)
#pragma unroll
            for (int pt = 0; pt < 4; ++pt) a2[ct][pt] = (f32x4){0.f, 0.f, 0.f, 0.f};
#pragma unroll
        for (int ks = 0; ks < 4; ++ks) {
            bf16x8 wf[4];
#pragma unroll
            for (int pt = 0; pt < 4; ++pt) { const float* wp = sw + ((size_t)(hh * 128 + ph * 64 + pt * 16 + L.fr) * 128 + ks * 32 + L.fq * 8);
                const f32x4 w0 = *(const f32x4*)wp, w1 = *(const f32x4*)(wp + 4); wf[pt] = __builtin_bit_cast(bf16x8, pack8(w0, w1)); }
#pragma unroll
            for (int ct = 0; ct < 4; ++ct) { const bf16x8 vf = *(const LAS bf16x8*)(VT + (hh * 64 + ct * 16 + L.fr) * 136 + ks * 32 + L.fq * 8);
#pragma unroll
                for (int pt = 0; pt < 4; ++pt) a2[ct][pt] = __builtin_amdgcn_mfma_f32_16x16x32_bf16(vf, wf[pt], a2[ct][pt], 0, 0, 0); }
        }
#pragma unroll
        for (int pt = 0; pt < 4; ++pt) { const int pp = ph * 64 + pt * 16 + L.fr, t = t0 + pp; const float bias = sb[hh * 128 + pp];
#pragma unroll
            for (int ct = 0; ct < 4; ++ct) { const int c = hh * 64 + ct * 16 + 4 * L.fq; const u32x2 u = *(const u32x2*)(Z + (size_t)t * 1536 + 768 + c);
                u32x2 w; w.x = cvt_pk_bf16(bflo(u.x) * (a2[ct][pt][0] + bias), bfhi(u.x) * (a2[ct][pt][1] + bias)); w.y = cvt_pk_bf16(bflo(u.y) * (a2[ct][pt][2] + bias), bfhi(u.y) * (a2[ct][pt][3] + bias));
                *(u32x2*)(BR2 + (size_t)t * 256 + c) = w; } }
    }
}

__device__ __forceinline__ void phase_gate_branch(int wv, const Params& p, LAS unsigned char* lds, int l) {
    const Lane L = get_lane(wv);
    const bf16_t* xb = (const bf16_t*)p.out; const unsigned char* wl = p.ws + WS_W + (size_t)l * W_LAYER;
    const bf16_t* Wg = (const bf16_t*)(wl + W_G); const bf16_t* Wb = (const bf16_t*)(wl + W_B); const bf16_t* BR = (const bf16_t*)(p.ws + WS_BR);
    const float* bg = p.in[16] + (size_t)l * 4 * 1024; bf16_t* MRG = (bf16_t*)(p.ws + WS_MRG);
    unsigned char* scr = p.ws + WS_SCR + (size_t)L.bid * 393216;
    const int G = gridDim.x, bid = L.bid;
    auto next = [=](int k, GU& u) -> bool { int pm, pn; if (!tile_order((k >> 3) * G + bid, 320, 4, pm, pn)) return false;
        const int sub = k & 7, i = sub >> 1; u.pm = pm; u.pn = pn; u.aux = sub;
        if (!(sub & 1)) { u.A = (const char*)(xb + (size_t)pm * 256 * 1024); u.B = (const char*)(Wg + (size_t)(i * 1024 + pn * 256) * 1024); u.K = 1024; }
        else { u.A = (const char*)(BR + ((size_t)i * T + (size_t)pm * 256) * 256); u.B = (const char*)(Wb + ((size_t)i * 1024 + pn * 256) * 256); u.K = 256; }
        return true; };
    auto epi = [=](f32x4 (&acc)[2][2][4][2], const GU& u) {
        unsigned loff = (unsigned)L.tid * 16u; asm volatile("" : "+v"(loff));
        const int i = u.aux >> 1; const int col0 = u.pn * 256 + L.wc * 32 + 8 * L.fq;
        if (!(u.aux & 1)) {
#pragma unroll
            for (int bj = 0; bj < 2; ++bj) { const f32x4 b0 = *(const f32x4*)(bg + i * 1024 + col0 + bj * 128), b1 = *(const f32x4*)(bg + i * 1024 + col0 + bj * 128 + 4);
#pragma unroll
                for (int ai = 0; ai < 2; ++ai)
#pragma unroll
                    for (int m = 0; m < 4; ++m) { f32x4 g0 = acc[ai][bj][m][0] + b0, g1 = acc[ai][bj][m][1] + b1;
#pragma unroll
                        for (int j = 0; j < 4; ++j) { g0[j] = sigmoid_f(g0[j]); g1[j] = sigmoid_f(g1[j]); }
                        *(u32x4*)(scr + (loff + (unsigned)((ai * 8 + bj * 4 + m) * 8192))) = pack8(g0, g1); asm volatile("" ::: "memory"); __builtin_amdgcn_sched_barrier(0); } }
        } else {
            int row0o = u.pm * 256 + L.wr * 64 + L.fr; asm volatile("" : "+v"(row0o));
            asm volatile("s_waitcnt vmcnt(0)" ::: "memory");
#pragma unroll
            for (int ai = 0; ai < 2; ++ai) {
                u32x4 g[8], q[8];
#pragma unroll
                for (int s8 = 0; s8 < 8; ++s8) { g[s8] = *(const u32x4*)(scr + (loff + (unsigned)((ai * 8 + s8) * 8192)));
                    if (i > 0) q[s8] = *(const u32x4*)(scr + (loff + (unsigned)(131072 + (ai * 8 + s8) * 8192))); else q[s8] = (u32x4){0u, 0u, 0u, 0u}; }
#pragma unroll
                for (int bj = 0; bj < 2; ++bj)
#pragma unroll
                    for (int m = 0; m < 4; ++m) { const int s8 = bj * 4 + m;
                        const f32x4 v0 = acc[ai][bj][m][0] * (f32x4){bflo(g[s8].x), bfhi(g[s8].x), bflo(g[s8].y), bfhi(g[s8].y)} + (f32x4){bflo(q[s8].x), bfhi(q[s8].x), bflo(q[s8].y), bfhi(q[s8].y)};
                        const f32x4 v1 = acc[ai][bj][m][1] * (f32x4){bflo(g[s8].z), bfhi(g[s8].z), bflo(g[s8].w), bfhi(g[s8].w)} + (f32x4){bflo(q[s8].z), bfhi(q[s8].z), bflo(q[s8].w), bfhi(q[s8].w)};
                        if (i < 3) *(u32x4*)(scr + (loff + (unsigned)(131072 + (ai * 8 + s8) * 8192))) = pack8(v0, v1);
                        else *(u32x4*)(MRG + (size_t)(row0o + ai * 128 + m * 16) * 1024 + col0 + bj * 128) = pack8_tb(v0, v1); }
                asm volatile("" ::: "memory"); __builtin_amdgcn_sched_barrier(0);
            }
        }
    };
    { f32x4 acc_[2][2][4][2]; gemm_stream<true, true, false>(L, lds, 1024, next, epi, acc_); }
}

#define XB_TMO      128
#define XB_XCNT(j)  (256  + 64 * (j))
#define XB_XSUB(j)  (1280 + 64 * (j))
#define XB_XGEN(j)  (2304 + 64 * (j))
#define XB_TOP      3328
#define XB_TOPGEN   3392
#define XCD_BAR_WORDS 3456
#define XB_SPIN_CAP (1u << 18)
constexpr size_t CTL_XBAR = 131072;
__device__ __forceinline__ unsigned xb_ld(unsigned* p)              { return __hip_atomic_load(p, __ATOMIC_RELAXED, __HIP_MEMORY_SCOPE_AGENT); }
__device__ __forceinline__ unsigned xb_add(unsigned* p, unsigned v) { return __hip_atomic_fetch_add(p, v, __ATOMIC_RELAXED, __HIP_MEMORY_SCOPE_AGENT); }
__device__ __forceinline__ unsigned xb_xcc_id() { return (unsigned)__builtin_amdgcn_s_getreg((3 << 11) | 20) & 0xFu; }
#define XB_SPIN(cond, bar) do { unsigned _sp = 0; while (cond) { __builtin_amdgcn_s_sleep(1); \
    if ((++_sp & 255u) == 0u) { if (xb_ld(&(bar)[XB_TMO])) break; if (_sp > XB_SPIN_CAP) { atomicAdd(&(bar)[XB_TMO], 1u); break; } } } } while (0)
__device__ __forceinline__ void xcd_barrier_complete(unsigned* bar, unsigned x, unsigned& nloc, unsigned& nx) {
    const unsigned G = gridDim.x;
    unsigned sum, cnt, mine, sp = 0u;
    for (;;) {
        sum = 0u; cnt = 0u; mine = 0u;
#pragma unroll
        for (unsigned j = 0; j < 16; ++j) { const unsigned c = xb_ld(&bar[XB_XCNT(j)]); sum += c; cnt += (c > 0u) ? 1u : 0u; mine = (j == x) ? c : mine; }
        if (sum == G) break;
        __builtin_amdgcn_s_sleep(1);
        if ((++sp & 255u) == 0u) { if (xb_ld(&bar[XB_TMO])) break; if (sp > XB_SPIN_CAP) { atomicAdd(&bar[XB_TMO], 1u); break; } }
    }
    nloc = mine > 0u ? mine : 1u; nx = cnt > 0u ? cnt : 1u;
}
__device__ __forceinline__ void xcd_barrier(int wv, unsigned* bar, volatile LAS unsigned* st) {
    asm volatile("s_waitcnt vmcnt(0)" ::: "memory");
    __syncthreads();
    if (wv == 0 && lane_id() == 0) {
        __builtin_amdgcn_s_waitcnt(0);
        const unsigned x = xb_xcc_id();
        unsigned nloc = st[0], nx = st[1];
        if (nloc == 0u) { xcd_barrier_complete(bar, x, nloc, nx); st[0] = nloc; st[1] = nx; }
        const unsigned old = xb_add(&bar[XB_XSUB(x)], 1u);
        const unsigned gen = old / nloc;
        if (old + 1u == (gen + 1u) * nloc) {
            __builtin_amdgcn_fence(__ATOMIC_RELEASE, "agent");
            asm volatile("s_waitcnt vmcnt(0)" ::: "memory");
            const unsigned og = xb_add(&bar[XB_TOP], 1u);
            const unsigned tg = og / nx;
            if (og + 1u == (tg + 1u) * nx) xb_add(&bar[XB_TOPGEN], 1u);
            else XB_SPIN(xb_ld(&bar[XB_TOPGEN]) == tg, bar);
            __builtin_amdgcn_fence(__ATOMIC_ACQUIRE, "agent");
            xb_add(&bar[XB_XGEN(x)], 1u);
            asm volatile("s_waitcnt vmcnt(0)" ::: "memory");
        } else {
            XB_SPIN(xb_ld(&bar[XB_XGEN(x)]) == gen, bar);
            __builtin_amdgcn_fence(__ATOMIC_ACQUIRE, "agent");
            asm volatile("s_waitcnt vmcnt(0)" ::: "memory");
        }
    }
    __syncthreads();
}

__global__ void __launch_bounds__(NTHREADS, 2) fwd_kernel(Params p) {
    extern __shared__ __attribute__((aligned(16))) unsigned char lds_raw[];
    LAS unsigned char* lds = (LAS unsigned char*)lds_raw;
    cg::grid_group grid = cg::this_grid();
    unsigned* bar = (unsigned*)(p.ws + CTL_XBAR);
    volatile LAS unsigned* bst = (volatile LAS unsigned*)(lds + LDS_BYTES - 16);
    const int wv = __builtin_amdgcn_readfirstlane((int)threadIdx.x >> 6);
    { const int t0 = wv * 64 + lane_id();
      if (t0 < 2) bst[t0] = 0u;
      if (blockIdx.x == 0) { for (int i = t0; i < XCD_BAR_WORDS; i += NTHREADS) __hip_atomic_store(bar + i, 0u, __ATOMIC_RELAXED, __HIP_MEMORY_SCOPE_AGENT);
          for (int i = t0; i < 320; i += NTHREADS) __hip_atomic_store((unsigned*)(p.ws + CTL_CNT) + 64 * i, 0u, __ATOMIC_RELAXED, __HIP_MEMORY_SCOPE_AGENT); }
      { unsigned long long* xz = (unsigned long long*)(p.ws + WS_XCH);
        for (size_t i = (size_t)blockIdx.x * NTHREADS + t0; i < (size_t)320 * 256 * 4; i += (size_t)gridDim.x * NTHREADS) __hip_atomic_store(xz + i, 0ull, __ATOMIC_RELAXED, __HIP_MEMORY_SCOPE_AGENT); }
      __syncthreads(); }
    for (int ph = p.ph_lo; ph < p.ph_hi; ++ph) {
        if (ph == p.ph_lo + 1) { grid.sync();
            if (wv == 0 && lane_id() == 0) (void)xb_add(&bar[XB_XCNT(xb_xcc_id())], 1u); }
        else if (ph > p.ph_lo + 1) xcd_barrier(wv, bar, bst);
        if (ph == 0) { phase_prep(wv, p, lds); continue; }
        const int l = (ph - 1) / 9, s = (ph - 1) % 9;
        const unsigned char* wl = p.ws + WS_W + (size_t)l * W_LAYER;
        if (s == 0 || s == 7) phase_ffn_up(wv, p, lds, l, s == 0 ? 0 : 1);
        else if (s == 1 || s == 8) phase_down_ln(wv, p, lds, (const bf16_t*)(p.ws + WS_H), DFF, (const bf16_t*)(wl + W_DN) + (size_t)(s == 1 ? 0 : 1) * 1024 * DFF, 0.5f, l, s == 1 ? 0 : 2);
        else if (s == 2) phase_mix_in(wv, p, lds, l);
        else if (s == 3) { phase_fold(wv, p); phase_mixers(wv, p, lds, l); }
        else if (s == 4) phase_dft(wv, p, lds);
        else if (s == 5) phase_gate_branch(wv, p, lds, l);
        else if (s == 6) phase_down_ln(wv, p, lds, (const bf16_t*)(p.ws + WS_MRG), 1024, (const bf16_t*)(wl + W_O), 1.0f, l, 1);
        __syncthreads();
    }
}

extern "C" void kernel_launch(void* const* d_in, const int* in_sizes, int n_in, void* d_out, int out_size, void* d_ws, size_t ws_size, hipStream_t stream) {
    static int grid = 0;
    if (grid == 0) {
        if (n_in != 19 || out_size != T * D || ws_size < WS_END) { fprintf(stderr, "kernel_launch: unexpected shapes (n_in %d, out %d, ws %zu)\n", n_in, out_size, ws_size); grid = -1; return; }
        int dev = 0, cus = 0, per_cu = 0;
        hipGetDevice(&dev); hipDeviceGetAttribute(&cus, hipDeviceAttributeMultiprocessorCount, dev);
        if (hipFuncSetAttribute((const void*)fwd_kernel, hipFuncAttributeMaxDynamicSharedMemorySize, LDS_BYTES) != hipSuccess) { fprintf(stderr, "kernel_launch: hipFuncSetAttribute failed\n"); grid = -1; return; }
        if (hipOccupancyMaxActiveBlocksPerMultiprocessor(&per_cu, (const void*)fwd_kernel, NTHREADS, LDS_BYTES) != hipSuccess || per_cu < 1) { fprintf(stderr, "kernel_launch: occupancy query says %d\n", per_cu); per_cu = 1; }
        (void)hipGetLastError();
        grid = cus * 1;
        fprintf(stderr, "kernel_launch: grid %d (cus %d, per_cu %d), ws %zu\n", grid, cus, per_cu, ws_size);
    }
    if (grid < 0) return;
    Params p{};
    for (int i = 0; i < 19; ++i) p.in[i] = (const float*)d_in[i];
    p.out = (float*)d_out; p.ws = (unsigned char*)d_ws;
#if N_LAUNCH_PER_PHASE
    for (int ph = 0; ph < NPHASE; ++ph) { p.ph_lo = ph; p.ph_hi = ph + 1; hipLaunchKernelGGL(fwd_kernel, dim3(grid), dim3(NTHREADS), LDS_BYTES, stream, p); }
#else
    p.ph_lo = 0; p.ph_hi = NPHASE;
    void* args[] = {&p};
    hipError_t e = hipLaunchCooperativeKernel((const void*)fwd_kernel, dim3(grid), dim3(NTHREADS), args, LDS_BYTES, stream);
    if (e != hipSuccess) fprintf(stderr, "cooperative launch failed: %s (grid %d)\n", hipGetErrorString(e), grid);
#endif
}
```
